# Optimizing an MI355X kernel written in HIP

```python
import jax, jax.numpy as jnp
from jax import lax
import numpy as np

D_MODEL = 2048
BATCH = 1
SEQ = 16384
DEPTH = 1

N_HEADS_SWA = 8
HEAD_DIM_SWA = 128
SWA_PATTERNS = ((128, 1), (512, 4), (2048, 16))
SWA_BLOCK = 128
N_HEADS_MLA = 8
Q_LORA_RANK = 512
KV_LORA_RANK = 256
QK_NOPE_DIM = 128
QK_ROPE_DIM = 64
V_HEAD_DIM = 128
ROPE_THETA = 10000.0
Q_BLOCK = 128
D_SWA = N_HEADS_SWA * HEAD_DIM_SWA
D_MLA = N_HEADS_MLA * V_HEAD_DIM
D_MIX = D_SWA + D_MLA
D_IN = 3 * D_SWA + Q_LORA_RANK + KV_LORA_RANK + QK_ROPE_DIM
N_EXPERTS = 64
N_GROUPS = 8
TOPK_GROUPS = 4
TOP_K = 8
D_EXPERT = 512
ROUTED_SCALE = 2.5
MOE_BLOCK = 128
N_ADA = 6
EPS = 1e-6
NEG_INF = -1e30

kernel_name = 'hybrid_dilated_mla_moe_adaln_layer'


def rms_norm(x, g):
    xf = x.astype(jnp.float32)
    y = xf * lax.rsqrt(jnp.mean(xf * xf, axis=-1, keepdims=True) + EPS)
    return (y * g.astype(jnp.float32)).astype(x.dtype)


def swiglu(x, w_gate, w_up, w_down):
    return (jax.nn.silu(x @ w_gate) * (x @ w_up)) @ w_down


def rope_tables(positions):
    half = QK_ROPE_DIM // 2
    inv_freq = ROPE_THETA ** (-jnp.arange(half, dtype=jnp.float32) / half)
    ang = positions.astype(jnp.float32)[..., None] * inv_freq
    return jnp.cos(ang), jnp.sin(ang)


def apply_rope(x, cos, sin):
    x1, x2 = jnp.split(x.astype(jnp.float32), 2, axis=-1)
    return jnp.concatenate([x1 * cos - x2 * sin, x2 * cos + x1 * sin], axis=-1).astype(x.dtype)


def dilated_window_pattern(q, k, v, pos, window, dilation, slopes):
    B, S, H, Dh = q.shape
    seg = dilation * SWA_BLOCK
    L = -(-S // seg) * seg
    pad = L - S
    nb = L // seg
    n_window = window // dilation

    def pad_seq(a):
        return jnp.pad(a, [(0, 0), (0, pad)] + [(0, 0)] * (a.ndim - 2))

    def strided(a):
        rest = a.shape[2:]
        a = a.reshape((B, L // dilation, dilation) + rest)
        a = jnp.moveaxis(a, 2, 1)
        return a.reshape((B, dilation, nb, SWA_BLOCK) + rest)

    def band(a):
        prev = jnp.pad(a[:, :, :-1], [(0, 0), (0, 0), (1, 0)] + [(0, 0)] * (a.ndim - 3))
        return jnp.concatenate([prev, a], axis=3)

    def unstrided(a):
        rest = a.shape[4:]
        a = a.reshape((B, dilation, L // dilation) + rest)
        a = jnp.moveaxis(a, 1, 2).reshape((B, L) + rest)
        return a[:, :S]

    posf = jnp.pad(pos.astype(jnp.float32), ((0, 0), (0, pad)), mode='edge')
    qb = strided(pad_seq(q))
    kb = band(strided(pad_seq(k)))
    vb = band(strided(pad_seq(v)))
    pq = strided(posf)
    pk = band(strided(posf))

    s = jnp.einsum('brnqhd,brnkhd->brnhqk', qb, kb,
                   preferred_element_type=jnp.float32) * (Dh ** -0.5)
    dist = jnp.abs(pq[..., :, None] - pk[..., None, :])
    s = s - slopes[:, None, None] * dist[:, :, :, None]
    i = jnp.arange(SWA_BLOCK)[:, None] + SWA_BLOCK
    j = jnp.arange(2 * SWA_BLOCK)[None, :]
    rel = i - j
    band_ok = (rel >= 0) & (rel <= n_window)
    first_ok = (jnp.arange(nb)[:, None, None] > 0) | (j[None] >= SWA_BLOCK)
    valid = band_ok[None] & first_ok
    s = jnp.where(valid[:, None], s, NEG_INF)
    m = jnp.max(s, axis=-1, keepdims=True)
    p = jnp.exp(s - m)
    den = jnp.sum(p, axis=-1)
    o = jnp.einsum('brnhqk,brnkhd->brnqhd', p, vb.astype(jnp.float32))
    o = o / jnp.swapaxes(den, 3, 4)[..., None]
    lse = jnp.swapaxes(m[..., 0] + jnp.log(den), 3, 4)
    return unstrided(o), unstrided(lse)


def dilated_attention(q, k, v, pos):
    H = q.shape[2]
    slopes = jnp.exp2(-8.0 * jnp.arange(1, H + 1, dtype=jnp.float32) / H)
    outs, lses = [], []
    for window, dilation in SWA_PATTERNS:
        o, lse = dilated_window_pattern(q, k, v, pos, window, dilation, slopes)
        outs.append(o)
        lses.append(lse)
    alpha = jax.nn.softmax(jnp.stack(lses, axis=0), axis=0)
    o = jnp.einsum('pbsh,pbshd->bshd', alpha, jnp.stack(outs, axis=0))
    return o.astype(q.dtype)


def causal_block_attention(q, k, v):
    B, S, H, Dk = q.shape
    nq = S // Q_BLOCK
    qb = jnp.moveaxis(q.reshape(B, nq, Q_BLOCK, H, Dk), 1, 0)
    kpos = jnp.arange(S)

    def one_block(args):
        qblk, bi = args
        s = jnp.einsum('bqhd,bkhd->bhqk', qblk, k,
                       preferred_element_type=jnp.float32) * (Dk ** -0.5)
        qpos = bi * Q_BLOCK + jnp.arange(Q_BLOCK)
        s = jnp.where(kpos[None, :] <= qpos[:, None], s, NEG_INF)
        p = jax.nn.softmax(s, axis=-1)
        return jnp.einsum('bhqk,bkhd->bqhd', p.astype(v.dtype), v)

    ob = lax.map(one_block, (qb, jnp.arange(nq)))
    return jnp.moveaxis(ob, 0, 1).reshape(B, S, H, v.shape[-1])


def latent_attention(c_q, c_kv, k_rope, positions, g_q, w_uq, g_kv, w_ukv):
    B, S, _ = c_q.shape
    q = (rms_norm(c_q, g_q) @ w_uq).reshape(B, S, N_HEADS_MLA, QK_NOPE_DIM + QK_ROPE_DIM)
    kv = (rms_norm(c_kv, g_kv) @ w_ukv).reshape(B, S, N_HEADS_MLA, QK_NOPE_DIM + V_HEAD_DIM)
    q_nope, q_rope = jnp.split(q, [QK_NOPE_DIM], axis=-1)
    k_nope, v = jnp.split(kv, [QK_NOPE_DIM], axis=-1)
    cos, sin = rope_tables(positions)
    q_rope = apply_rope(q_rope, cos[:, :, None], sin[:, :, None])
    k_rope = apply_rope(k_rope, cos, sin)[:, :, None, :]
    q = jnp.concatenate([q_nope, q_rope], axis=-1)
    k = jnp.concatenate([k_nope, jnp.broadcast_to(k_rope, k_nope.shape[:-1] + (QK_ROPE_DIM,))], axis=-1)
    return causal_block_attention(q, k, v)


def routed_experts(xt, eidx, wts, w_gate, w_up, w_down):
    N, D = xt.shape
    A = N * TOP_K
    flat_e = eidx.reshape(A)
    order = jnp.argsort(flat_e)
    sorted_e = flat_e[order]
    sorted_tok = (order // TOP_K).astype(jnp.int32)
    sorted_w = wts.reshape(A)[order]
    counts = jnp.bincount(flat_e, length=N_EXPERTS)
    padded = (counts + MOE_BLOCK - 1) // MOE_BLOCK * MOE_BLOCK
    seg_start = jnp.cumsum(counts) - counts
    pad_end = jnp.cumsum(padded)
    pad_start = pad_end - padded
    dest = pad_start[sorted_e] + jnp.arange(A) - seg_start[sorted_e]
    n_slots = -(-A // MOE_BLOCK) * MOE_BLOCK + N_EXPERTS * MOE_BLOCK
    n_blocks = n_slots // MOE_BLOCK
    slot_tok = jnp.full((n_slots,), N, jnp.int32).at[dest].set(sorted_tok)
    slot_w = jnp.zeros((n_slots,), jnp.float32).at[dest].set(sorted_w)
    blk_e = jnp.minimum(jnp.searchsorted(pad_end, jnp.arange(n_blocks) * MOE_BLOCK, side='right'),
                        N_EXPERTS - 1)
    x_pad = jnp.concatenate([xt, jnp.zeros((1, D), xt.dtype)], axis=0)

    def body(y, args):
        tok, wt, e = args
        yb = swiglu(x_pad[tok], w_gate[e], w_up[e], w_down[e])
        return y.at[tok].add(yb * wt[:, None].astype(yb.dtype)), None

    y, _ = lax.scan(body, jnp.zeros_like(x_pad),
                    (slot_tok.reshape(n_blocks, MOE_BLOCK), slot_w.reshape(n_blocks, MOE_BLOCK), blk_e))
    return y[:N]


def moe_ffn(h, w_router, router_bias, w_exp_gate, w_exp_up, w_exp_down, w_sh_gate, w_sh_up, w_sh_down):
    B, S, D = h.shape
    N = B * S
    xt = h.reshape(N, D)
    logits = jnp.einsum('nd,de->ne', xt, w_router, preferred_element_type=jnp.float32)
    scores = jax.nn.sigmoid(logits)
    choice = scores + router_bias.astype(jnp.float32)
    grp = choice.reshape(N, N_GROUPS, N_EXPERTS // N_GROUPS)
    grp_score = jnp.sum(lax.top_k(grp, 2)[0], axis=-1)
    _, gidx = lax.top_k(grp_score, TOPK_GROUPS)
    gmask = jnp.sum(jax.nn.one_hot(gidx, N_GROUPS, dtype=jnp.float32), axis=1)
    emask = jnp.repeat(gmask, N_EXPERTS // N_GROUPS, axis=1) > 0
    _, eidx = lax.top_k(jnp.where(emask, choice, NEG_INF), TOP_K)
    w = jnp.take_along_axis(scores, eidx, axis=-1)
    w = w / jnp.sum(w, axis=-1, keepdims=True) * ROUTED_SCALE
    routed = routed_experts(xt, eidx, w, w_exp_gate, w_exp_up, w_exp_down)
    shared = swiglu(xt, w_sh_gate, w_sh_up, w_sh_down)
    return (routed + shared).reshape(B, S, D)


def hybrid_layer(x, c, positions, norm_attn_g, w_ada, b_ada, w_in, g_q, w_uq, g_kv, w_ukv,
                 g_out_swa, g_out_mla, w_o, norm_ffn_g, w_router, router_bias,
                 w_exp_gate, w_exp_up, w_exp_down, w_sh_gate, w_sh_up, w_sh_down):
    B, S, _ = x.shape
    mod = jnp.einsum('bd,de->be', jax.nn.silu(c), w_ada) + b_ada
    shift_a, scale_a, gate_a, shift_f, scale_f, gate_f = [m[:, None, :] for m in jnp.split(mod, N_ADA, axis=-1)]

    h = rms_norm(x, norm_attn_g) * (1 + scale_a) + shift_a
    proj = h @ w_in
    q_a, k_a, v_a, c_q, c_kv, k_rope = jnp.split(
        proj, [D_SWA, 2 * D_SWA, 3 * D_SWA, 3 * D_SWA + Q_LORA_RANK,
               3 * D_SWA + Q_LORA_RANK + KV_LORA_RANK], axis=-1)
    heads = lambda a: a.reshape(B, S, N_HEADS_SWA, HEAD_DIM_SWA)
    o_a = dilated_attention(heads(q_a), heads(k_a), heads(v_a), positions).reshape(B, S, D_SWA)
    o_b = latent_attention(c_q, c_kv, k_rope, positions, g_q, w_uq, g_kv, w_ukv).reshape(B, S, D_MLA)
    mix = jnp.concatenate([rms_norm(o_a, g_out_swa), rms_norm(o_b, g_out_mla)], axis=-1)
    x = x + gate_a * (mix @ w_o)

    h = rms_norm(x, norm_ffn_g) * (1 + scale_f) + shift_f
    x = x + gate_f * moe_ffn(h, w_router, router_bias, w_exp_gate, w_exp_up, w_exp_down,
                             w_sh_gate, w_sh_up, w_sh_down)
    return x


def setup_inputs(seed: int = 0) -> dict:
    key = jax.random.key(seed)
    ks = jax.random.split(key, 24)
    f32 = jnp.float32
    L, D, E = DEPTH, D_MODEL, N_EXPERTS

    def nrm(k, shape, scale):
        return jax.random.normal(k, shape, f32) * scale

    def gain(k, shape):
        return 1.0 + 0.02 * jax.random.normal(k, shape, f32)

    start = jax.random.randint(ks[2], (BATCH, 1), 0, 4096, dtype=jnp.int32)
    positions = start + jnp.arange(SEQ, dtype=jnp.int32)[None, :]
    return {
        'x': nrm(ks[0], (BATCH, SEQ, D), 1.0),
        'c': nrm(ks[1], (BATCH, D), 1.0),
        'positions': positions,
        'norm_attn_g': gain(ks[3], (L, D)),
        'w_ada': nrm(ks[4], (L, D, N_ADA * D), 0.5 * D ** -0.5),
        'b_ada': nrm(ks[5], (L, N_ADA * D), 0.02),
        'w_in': nrm(ks[6], (L, D, D_IN), D ** -0.5),
        'g_q': gain(ks[7], (L, Q_LORA_RANK)),
        'w_uq': nrm(ks[8], (L, Q_LORA_RANK, N_HEADS_MLA * (QK_NOPE_DIM + QK_ROPE_DIM)), Q_LORA_RANK ** -0.5),
        'g_kv': gain(ks[9], (L, KV_LORA_RANK)),
        'w_ukv': nrm(ks[10], (L, KV_LORA_RANK, N_HEADS_MLA * (QK_NOPE_DIM + V_HEAD_DIM)), KV_LORA_RANK ** -0.5),
        'g_out_swa': gain(ks[11], (L, D_SWA)),
        'g_out_mla': gain(ks[12], (L, D_MLA)),
        'w_o': nrm(ks[13], (L, D_MIX, D), D_MIX ** -0.5),
        'norm_ffn_g': gain(ks[14], (L, D)),
        'w_router': nrm(ks[15], (L, D, E), D ** -0.5),
        'router_bias': nrm(ks[16], (L, E), 0.01),
        'w_exp_gate': nrm(ks[17], (L, E, D, D_EXPERT), D ** -0.5),
        'w_exp_up': nrm(ks[18], (L, E, D, D_EXPERT), D ** -0.5),
        'w_exp_down': nrm(ks[19], (L, E, D_EXPERT, D), D_EXPERT ** -0.5),
        'w_sh_gate': nrm(ks[20], (L, D, D_EXPERT), D ** -0.5),
        'w_sh_up': nrm(ks[21], (L, D, D_EXPERT), D ** -0.5),
        'w_sh_down': nrm(ks[22], (L, D_EXPERT, D), D_EXPERT ** -0.5),
        'final_norm_g': gain(ks[23], (D,)),
    }


def reference(x, c, positions, norm_attn_g, w_ada, b_ada, w_in, g_q, w_uq, g_kv, w_ukv,
              g_out_swa, g_out_mla, w_o, norm_ffn_g, w_router, router_bias,
              w_exp_gate, w_exp_up, w_exp_down, w_sh_gate, w_sh_up, w_sh_down, final_norm_g):
    for l in range(DEPTH):
        x = hybrid_layer(x, c, positions, norm_attn_g[l], w_ada[l], b_ada[l], w_in[l], g_q[l], w_uq[l],
                         g_kv[l], w_ukv[l], g_out_swa[l], g_out_mla[l], w_o[l], norm_ffn_g[l],
                         w_router[l], router_bias[l], w_exp_gate[l], w_exp_up[l], w_exp_down[l],
                         w_sh_gate[l], w_sh_up[l], w_sh_down[l])
    return rms_norm(x, final_norm_g)
```

```cpp
#include <hip/hip_runtime.h>
#include <cstdio>
#include <cstdint>

#ifndef MK_N_LAUNCHES
#define MK_N_LAUNCHES 1
#endif

#define LAS __attribute__((address_space(3)))
#define GAS __attribute__((address_space(1)))
typedef unsigned short bf16_t;
typedef short bf16x8 __attribute__((ext_vector_type(8)));
typedef short s16x4 __attribute__((ext_vector_type(4)));
typedef float f32x4 __attribute__((ext_vector_type(4)));
typedef float f32x16 __attribute__((ext_vector_type(16)));
typedef unsigned u32x4 __attribute__((ext_vector_type(4)));
typedef unsigned u32x2 __attribute__((ext_vector_type(2)));

constexpr int S_ = 16384, DM = 2048, D_INP = 4096;
constexpr int NEXP = 64, NE1 = 65;
constexpr int MAX_TILES = 642, MAX_SLOTS = MAX_TILES * 256;
constexpr float EPS_ = 1e-6f;

__device__ __forceinline__ unsigned cvt_pk_bf16(float lo, float hi) { unsigned r; asm volatile("v_cvt_pk_bf16_f32 %0, %1, %2" : "=v"(r) : "v"(lo), "v"(hi)); return r; }
__device__ __forceinline__ unsigned f2bf(float f) { unsigned u = __builtin_bit_cast(unsigned, f); return (u + 0x7fffu + ((u >> 16) & 1u)) >> 16; }
__device__ __forceinline__ unsigned pk2(float lo, float hi) { return f2bf(lo) | (f2bf(hi) << 16); }
__device__ __forceinline__ float bf_lo(unsigned w) { return __builtin_bit_cast(float, w << 16); }
__device__ __forceinline__ float bf_hi(unsigned w) { return __builtin_bit_cast(float, w & 0xffff0000u); }
__device__ __forceinline__ float wave_sum(float v) {
#pragma unroll
    for (int o = 1; o < 64; o <<= 1) v += __shfl_xor(v, o);
    return v;
}

namespace pg8 {
constexpr int BM = 256, BK = 64, HALF = 128, HTB = HALF * BK * 2, STAGE_BYTES = 8 * HTB, NXCD = 8, WGM = 8;
__host__ __device__ __forceinline__ int lds_byte(int r, int c) { const int st = (r >> 4) * 2 + (c >> 5), rr = r & 15, cc = c & 31, ob = rr * 64 + cc * 2; return st * 1024 + (ob ^ (((ob >> 9) & 1) << 5)); }
__host__ __device__ __forceinline__ void stage_rc(int b, int& R, int& C) { const int st = b / 1024, sb = b % 1024, swz = sb ^ (((sb >> 9) & 1) << 5); R = (st >> 1) * 16 + swz / 64; C = (st & 1) * 32 + (swz % 64) / 2; }
__host__ __device__ __forceinline__ int perm32(int rho) { const int n = rho >> 4, i = rho & 15; return 8 * (i >> 2) + 4 * n + (i & 3); }

struct Unit { int pm, pn, pb, e; };
struct Gemm { const bf16_t* A; const bf16_t* Bt; int lda, K; };

struct StaticOrder {
    int nM, nN, nwg, G, c;
    __host__ __device__ void init(int M, int N, int G_, int c_) { nM = M / BM; nN = N / BM; nwg = nM * nN; G = G_; c = c_; }
    __host__ __device__ bool next(int i, Unit& u) const {
        const long L = (long)i * G + c; if (L >= nwg) return false;
        int wgid = (int)L; { const int q = nwg / NXCD, r = nwg % NXCD, xcd = wgid % NXCD, off = wgid / NXCD; wgid = (xcd < r ? xcd * (q + 1) : r * (q + 1) + (xcd - r) * q) + off; }
        const int nig = WGM * nN, gid = wgid / nig, fm = gid * WGM, gsz = (nM - fm) < WGM ? (nM - fm) : WGM;
        u.pm = fm + ((wgid % nig) % gsz); u.pn = (wgid % nig) / gsz; u.pb = u.pn; u.e = 0; return true;
    }
};
struct GroupedOrder {
    const LAS int* tile_e; int npn, nunits, G, c;
    __device__ bool next(int i, Unit& u) const {
        const long L = (long)i * G + c; if (L >= nunits) return false;
        const int tile = (int)L / npn, pn = (int)L % npn, e = tile_e[tile];
        u.pm = tile; u.pn = pn; u.pb = e * npn + pn; u.e = e; return true;
    }
};
struct RowIdent { __device__ __forceinline__ int operator()(int r) const { return r; } };
struct RowGather { const int* tok; __device__ __forceinline__ int operator()(int r) const { return tok[r]; } };

template <class Epi, class Sched, class RowMap>
__device__ __forceinline__ void gemm_phase(LAS unsigned char* lds, const Gemm g, const Sched& S, const Epi& E, const RowMap& RM) {
    const int tid = threadIdx.x, wid = __builtin_amdgcn_readfirstlane(tid >> 6), lane = tid & 63, wr = wid >> 2, wc = wid & 3, fr = lane & 15, fq = lane >> 4;
    const int K = g.K, nt = K / BK;
    unsigned voffB[2]; int Rr[2], Cc[2];
#pragma unroll
    for (int i = 0; i < 2; ++i) { int R, C; stage_rc(tid * 16 + i * 8192, R, C); const int Rb = Epi::PERM ? ((R & ~31) + perm32(R & 31)) : R;
        Rr[i] = R; Cc[i] = C; voffB[i] = (unsigned)(Rb * K + C) * 2u; }
    const size_t kstep = (size_t)(BK * 2);
    const size_t hstep = (size_t)HALF * K * 2;
    const size_t tstep = 2 * hstep;
    const unsigned ldsw = (unsigned)wid * 1024u;
    const int aoff = lds_byte(wr * 64 + fr, fq * 8), boff = lds_byte(wc * 32 + fr, fq * 8);
#define PG8_SA(b, h) (((b) * 2 + (h)) * HTB)
#define PG8_SB(b, h) ((4 + (b) * 2 + (h)) * HTB)
#define PG8_STAGE(bufoff, gbase, voff) do { _Pragma("unroll") for (int _i = 0; _i < 2; ++_i) \
        __builtin_amdgcn_global_load_lds((const unsigned*)((const char*)(gbase) + (voff)[_i]), (LAS unsigned*)(lds + (bufoff) + ldsw + _i * 8192), 16, 0, 0); } while (0)
#define PG8_LDA(dst, b, h) do { _Pragma("unroll") for (int m = 0; m < 4; ++m) _Pragma("unroll") for (int k = 0; k < 2; ++k) dst[m][k] = *(const LAS bf16x8*)(lds + PG8_SA(b, h) + aoff + m * 2048 + k * 1024); } while (0)
#define PG8_LDB(dst, b, h) do { _Pragma("unroll") for (int n = 0; n < 2; ++n) _Pragma("unroll") for (int k = 0; k < 2; ++k) dst[n][k] = *(const LAS bf16x8*)(lds + PG8_SB(b, h) + boff + n * 2048 + k * 1024); } while (0)
#define PG8_MMA(ai, bj, At, Bt) do { __builtin_amdgcn_s_setprio(1); _Pragma("unroll") for (int m = 0; m < 4; ++m) _Pragma("unroll") for (int n = 0; n < 2; ++n) _Pragma("unroll") for (int k = 0; k < 2; ++k) \
        acc[ai][bj][m][n] = __builtin_amdgcn_mfma_f32_16x16x32_bf16(Bt[n][k], At[m][k], acc[ai][bj][m][n], 0, 0, 0); __builtin_amdgcn_s_setprio(0); } while (0)
#define PG8_WAIT_V(n) asm volatile("s_waitcnt vmcnt(" #n ")" ::: "memory")
#define PG8_WAIT_L(n) asm volatile("s_waitcnt lgkmcnt(" #n ")" ::: "memory")
#define PG8_BAR __builtin_amdgcn_s_barrier()
#define PG8_SCHED __builtin_amdgcn_sched_barrier(0)
#define PG8_VOFF(u, v) do { _Pragma("unroll") for (int _h = 0; _h < 2; ++_h) _Pragma("unroll") for (int _i = 0; _i < 2; ++_i) \
        v[_h][_i] = (unsigned)(((size_t)RM((u).pm * BM + _h * HALF + Rr[_i]) * (size_t)g.lda + (size_t)Cc[_i]) * 2u); } while (0)
    Unit cur, nxt; int ui = 0;
    if (!S.next(0, cur)) return;
    f32x4 acc[2][2][4][2];
#pragma unroll
    for (int a = 0; a < 2; ++a)
#pragma unroll
        for (int b = 0; b < 2; ++b)
#pragma unroll
            for (int m = 0; m < 4; ++m)
#pragma unroll
                for (int n = 0; n < 2; ++n) acc[a][b][m][n] = (f32x4){0.f, 0.f, 0.f, 0.f};
    bf16x8 At[4][2], B0[2][2], B1[2][2];
    unsigned vc[2][2], vn[2][2];
    PG8_VOFF(cur, vc);
    const char* pA = (const char*)g.A;
    const char* cB = (const char*)g.Bt + (size_t)cur.pb * tstep;
    PG8_STAGE(PG8_SB(0, 0), cB, voffB); PG8_STAGE(PG8_SB(0, 1), cB + hstep, voffB); PG8_STAGE(PG8_SA(0, 0), pA, vc[0]); PG8_STAGE(PG8_SA(0, 1), pA, vc[1]);
    if (wr == 1) PG8_BAR;
    PG8_WAIT_V(2); PG8_BAR;
    PG8_STAGE(PG8_SB(1, 0), cB + kstep, voffB); PG8_STAGE(PG8_SA(1, 0), pA + kstep, vc[0]); PG8_STAGE(PG8_SB(1, 1), cB + hstep + kstep, voffB);
    PG8_WAIT_V(6); PG8_BAR;
    for (;;) {
        const bool has_next = S.next(ui + 1, nxt);
        if (has_next) { PG8_VOFF(nxt, vn); } else { vn[0][0] = vc[0][0]; vn[0][1] = vc[0][1]; vn[1][0] = vc[1][0]; vn[1][1] = vc[1][1]; }
        const char* nB = has_next ? (const char*)g.Bt + (size_t)nxt.pb * tstep : cB;
        for (int t = 0; t < nt; t += 2) {
            const bool last = (t == nt - 2);
            const char* a1 = pA + (size_t)(t + 1) * kstep;
            const char* a2 = last ? pA : pA + (size_t)(t + 2) * kstep; const char* b2 = last ? nB : cB + (size_t)(t + 2) * kstep;
            const char* a3 = a2 + kstep; const char* b3 = b2 + kstep;
            unsigned v2[2][2];
            v2[0][0] = last ? vn[0][0] : vc[0][0]; v2[0][1] = last ? vn[0][1] : vc[0][1]; v2[1][0] = last ? vn[1][0] : vc[1][0]; v2[1][1] = last ? vn[1][1] : vc[1][1];
            PG8_LDB(B0, 0, 0); PG8_LDB(B1, 0, 1); PG8_SCHED; PG8_LDA(At, 0, 0); PG8_STAGE(PG8_SA(1, 1), a1, vc[1]);
            PG8_WAIT_V(8); PG8_WAIT_L(0); PG8_BAR; PG8_MMA(0, 0, At, B0); PG8_MMA(0, 1, At, B1); PG8_BAR; PG8_SCHED;
            PG8_LDA(At, 0, 1); PG8_STAGE(PG8_SB(0, 0), b2, voffB); PG8_STAGE(PG8_SB(0, 1), b2 + hstep, voffB); PG8_STAGE(PG8_SA(0, 0), a2, v2[0]);
            PG8_WAIT_V(8); PG8_WAIT_L(0); PG8_BAR; PG8_MMA(1, 0, At, B0); PG8_MMA(1, 1, At, B1); PG8_BAR; PG8_SCHED;
            PG8_LDB(B0, 1, 0); PG8_LDB(B1, 1, 1); PG8_SCHED; PG8_LDA(At, 1, 0); PG8_STAGE(PG8_SA(0, 1), a2, v2[1]);
            PG8_WAIT_V(8); PG8_WAIT_L(0); PG8_BAR; PG8_MMA(0, 0, At, B0); PG8_MMA(0, 1, At, B1); PG8_BAR; PG8_SCHED;
            PG8_LDA(At, 1, 1); PG8_STAGE(PG8_SB(1, 0), b3, voffB); PG8_STAGE(PG8_SB(1, 1), b3 + hstep, voffB); PG8_STAGE(PG8_SA(1, 0), a3, v2[0]);
            PG8_WAIT_V(8); PG8_WAIT_L(0); PG8_BAR; PG8_MMA(1, 0, At, B0); PG8_MMA(1, 1, At, B1); PG8_BAR; PG8_SCHED;
        }
        if (wr == 0) PG8_BAR;
        E(acc, cur, wr, wc, fr, fq);
        if (!has_next) break;
#pragma unroll
        for (int a = 0; a < 2; ++a)
#pragma unroll
            for (int b = 0; b < 2; ++b)
#pragma unroll
                for (int m = 0; m < 4; ++m)
#pragma unroll
                    for (int n = 0; n < 2; ++n) acc[a][b][m][n] = (f32x4){0.f, 0.f, 0.f, 0.f};
        cur = nxt; cB = nB; ++ui;
        vc[0][0] = vn[0][0]; vc[0][1] = vn[0][1]; vc[1][0] = vn[1][0]; vc[1][1] = vn[1][1];
        if (wr == 1) PG8_BAR;
    }
    PG8_WAIT_V(0);
    PG8_BAR;
#undef PG8_SA
#undef PG8_SB
#undef PG8_STAGE
#undef PG8_LDA
#undef PG8_LDB
#undef PG8_MMA
#undef PG8_WAIT_V
#undef PG8_WAIT_L
#undef PG8_BAR
#undef PG8_SCHED
#undef PG8_VOFF
}
}
namespace pg8 {
__device__ __forceinline__ u32x4 pack8s(f32x4 v0, f32x4 v1, float sc) {
    u32x4 w; w.x = cvt_pk_bf16(v0[0] * sc, v0[1] * sc); w.y = cvt_pk_bf16(v0[2] * sc, v0[3] * sc); w.z = cvt_pk_bf16(v1[0] * sc, v1[1] * sc); w.w = cvt_pk_bf16(v1[2] * sc, v1[3] * sc); return w;
}
struct EpiBf16R {
    static constexpr bool PERM = true;
    bf16_t* O; int ldc; const float* rs;
    __device__ __forceinline__ void operator()(const f32x4 (&acc)[2][2][4][2], const Unit& u, int wr, int wc, int fr, int fq) const {
        const int row0 = u.pm * BM + wr * 64 + fr, col0 = u.pn * BM + wc * 32 + 8 * fq;
#pragma unroll
        for (int ai = 0; ai < 2; ++ai)
#pragma unroll
            for (int m = 0; m < 4; ++m) { const int row = row0 + ai * HALF + m * 16; const float sc = rs ? rs[row] : 1.f; bf16_t* rowp = O + (size_t)row * ldc + col0;
#pragma unroll
                for (int bj = 0; bj < 2; ++bj) *(u32x4*)(rowp + bj * HALF) = pack8s(acc[ai][bj][m][0], acc[ai][bj][m][1], sc); }
    }
};
struct EpiQ {
    static constexpr bool PERM = true;
    bf16_t* QM; const float* rq; const float* COS; const float* SIN;
    __device__ __forceinline__ void operator()(const f32x4 (&acc)[2][2][4][2], const Unit& u, int wr, int wc, int fr, int fq) const {
        const int row0 = u.pm * BM + wr * 64 + fr;
        if (u.pn < 4) {
            const int col0 = u.pn * BM + wc * 32 + 8 * fq;
#pragma unroll
            for (int ai = 0; ai < 2; ++ai)
#pragma unroll
                for (int m = 0; m < 4; ++m) { const int row = row0 + ai * HALF + m * 16; const float sc = rq[row]; bf16_t* rowp = QM + (size_t)row * 1536 + col0;
#pragma unroll
                    for (int bj = 0; bj < 2; ++bj) *(u32x4*)(rowp + bj * HALF) = pack8s(acc[ai][bj][m][0], acc[ai][bj][m][1], sc); }
        } else {
            const int head = 4 * (u.pn - 4) + wc, j0 = 8 * fq;
#pragma unroll
            for (int ai = 0; ai < 2; ++ai)
#pragma unroll
                for (int m = 0; m < 4; ++m) { const int row = row0 + ai * HALF + m * 16; const float sc = rq[row];
                    const f32x4 c0 = *(const f32x4*)(COS + (size_t)row * 32 + j0), c1 = *(const f32x4*)(COS + (size_t)row * 32 + j0 + 4);
                    const f32x4 s0 = *(const f32x4*)(SIN + (size_t)row * 32 + j0), s1 = *(const f32x4*)(SIN + (size_t)row * 32 + j0 + 4);
                    const f32x4 x1a = acc[ai][0][m][0], x1b = acc[ai][0][m][1], x2a = acc[ai][1][m][0], x2b = acc[ai][1][m][1];
                    const f32x4 o1a = x1a * c0 - x2a * s0, o1b = x1b * c1 - x2b * s1, o2a = x2a * c0 + x1a * s0, o2b = x2b * c1 + x1b * s1;
                    bf16_t* rowp = QM + (size_t)row * 1536 + 1024 + head * 64 + j0;
                    *(u32x4*)(rowp) = pack8s(o1a, o1b, sc); *(u32x4*)(rowp + 32) = pack8s(o2a, o2b, sc); }
        }
    }
};
struct EpiWo {
    static constexpr bool PERM = false;
    const float* x; const float* gate; float* out;
    __device__ __forceinline__ void operator()(const f32x4 (&acc)[2][2][4][2], const Unit& u, int wr, int wc, int fr, int fq) const {
        const int row0 = u.pm * BM + wr * 64 + fr, col0 = u.pn * BM + wc * 32 + 4 * fq;
        f32x4 gv[2][2];
#pragma unroll
        for (int bj = 0; bj < 2; ++bj)
#pragma unroll
            for (int n = 0; n < 2; ++n) gv[bj][n] = *(const f32x4*)(gate + col0 + bj * HALF + n * 16);
#pragma unroll
        for (int ai = 0; ai < 2; ++ai)
#pragma unroll
            for (int m = 0; m < 4; ++m) { const size_t off = (size_t)(row0 + ai * HALF + m * 16) * DM + col0;
#pragma unroll
                for (int bj = 0; bj < 2; ++bj)
#pragma unroll
                    for (int n = 0; n < 2; ++n) { const f32x4 xin = *(const f32x4*)(x + off + bj * HALF + n * 16); *(f32x4*)(out + off + bj * HALF + n * 16) = xin + gv[bj][n] * acc[ai][bj][m][n]; }
                if (m & 1) asm volatile("" ::: "memory"); }
    }
};
struct EpiLogits {
    static constexpr bool PERM = false;
    float* L;
    __device__ __forceinline__ void operator()(const f32x4 (&acc)[2][2][4][2], const Unit& u, int wr, int wc, int fr, int fq) const {
        if (wc >= 2) return;
        const int row0 = u.pm * BM + wr * 64 + fr, col0 = wc * 32 + 4 * fq;
#pragma unroll
        for (int ai = 0; ai < 2; ++ai)
#pragma unroll
            for (int m = 0; m < 4; ++m) { float* rowp = L + (size_t)(row0 + ai * HALF + m * 16) * 64 + col0;
#pragma unroll
                for (int n = 0; n < 2; ++n) *(f32x4*)(rowp + n * 16) = acc[ai][0][m][n]; }
    }
};
__device__ __forceinline__ float silu_mul(float g, float u) { return g * __builtin_amdgcn_rcpf(1.f + __builtin_amdgcn_exp2f(-1.4426950408889634f * g)) * u; }
struct EpiAct {
    static constexpr bool PERM = true;
    bf16_t* ACT;
    __device__ __forceinline__ void operator()(const f32x4 (&acc)[2][2][4][2], const Unit& u, int wr, int wc, int fr, int fq) const {
        const int row0 = u.pm * BM + wr * 64 + fr, col0 = u.pn * HALF + wc * 32 + 8 * fq;
#pragma unroll
        for (int ai = 0; ai < 2; ++ai)
#pragma unroll
            for (int m = 0; m < 4; ++m) { bf16_t* rowp = ACT + (size_t)(row0 + ai * HALF + m * 16) * 512 + col0;
                const f32x4 g0 = acc[ai][0][m][0], g1 = acc[ai][0][m][1], u0 = acc[ai][1][m][0], u1 = acc[ai][1][m][1];
                u32x4 w;
                w.x = cvt_pk_bf16(silu_mul(g0[0], u0[0]), silu_mul(g0[1], u0[1])); w.y = cvt_pk_bf16(silu_mul(g0[2], u0[2]), silu_mul(g0[3], u0[3]));
                w.z = cvt_pk_bf16(silu_mul(g1[0], u1[0]), silu_mul(g1[1], u1[1])); w.w = cvt_pk_bf16(silu_mul(g1[2], u1[2]), silu_mul(g1[3], u1[3]));
                *(u32x4*)rowp = w; }
    }
};
struct EpiDown {
    static constexpr bool PERM = true;
    bf16_t* YS; float* X1; const float* gatef; const int* dst; const float* w; const int* tok;
    __device__ __forceinline__ void operator()(const f32x4 (&acc)[2][2][4][2], const Unit& u, int wr, int wc, int fr, int fq) const {
        const int row0 = u.pm * BM + wr * 64 + fr, col0 = u.pn * BM + wc * 32 + 8 * fq;
        if (u.e == NEXP) {
            f32x4 gv[2][2];
#pragma unroll
            for (int bj = 0; bj < 2; ++bj)
#pragma unroll
                for (int n = 0; n < 2; ++n) gv[bj][n] = *(const f32x4*)(gatef + col0 + bj * HALF + n * 4);
#pragma unroll
            for (int ai = 0; ai < 2; ++ai)
#pragma unroll
                for (int m = 0; m < 4; ++m) { const int t = tok[row0 + ai * HALF + m * 16]; float* rowp = X1 + (size_t)t * DM + col0;
#pragma unroll
                    for (int bj = 0; bj < 2; ++bj)
#pragma unroll
                        for (int n = 0; n < 2; ++n) { f32x4* p = (f32x4*)(rowp + bj * HALF + n * 4); *p = *p + gv[bj][n] * acc[ai][bj][m][n]; }
                    if (m & 1) asm volatile("" ::: "memory"); }
        } else {
#pragma unroll
            for (int ai = 0; ai < 2; ++ai)
#pragma unroll
                for (int m = 0; m < 4; ++m) { const int slot = row0 + ai * HALF + m * 16; const int d = dst[slot]; const float sc = w[slot];
                    if (d >= 0) { bf16_t* rowp = YS + (size_t)d * DM + col0;
#pragma unroll
                        for (int bj = 0; bj < 2; ++bj) *(u32x4*)(rowp + bj * HALF) = pack8s(acc[ai][bj][m][0], acc[ai][bj][m][1], sc); } }
        }
    }
};
}
namespace att {
constexpr int NW = 8, QBLK = 32, KVBLK = 64, QB = NW * QBLK, D = 128;
constexpr int SHM_V = KVBLK * D * 2, SHM_K = KVBLK * D * 2;
constexpr int OFF_V = 0, OFF_K = 2 * SHM_V, OFF_WS = OFF_K + 2 * SHM_K, OFF_KR = OFF_WS + NW * 64 * 4, SHM_KR = KVBLK * 64 * 2, OFF_POS = OFF_KR + 2 * SHM_KR, LDS_BYTES = OFF_POS + 2 * 256;
static_assert(LDS_BYTES <= 131072, "attention LDS inside the ring region");

#define KSWZ(row, colB) ((row) * 256 + ((colB) ^ (((row) & 7) << 4)))
#define KRSWZ(row, chunk) ((row) * 128 + ((((chunk) ^ ((row) & 7))) << 4))
#define SBAR() __builtin_amdgcn_sched_barrier(0)
__device__ __forceinline__ int v_st(int k, int c) { const int kk = (k & ~0xC) | ((k & 4) << 1) | ((k & 8) >> 1); return ((kk >> 3) * 4 + (c >> 5)) * 512 + ((kk & 7) * 32 + (c & 31)) * 2; }
__device__ __forceinline__ int v_rd_base(int lane) { return ((lane & 3) << 3) | (((lane >> 2) & 3) << 6) | (((lane >> 4) & 1) << 5) | (((lane >> 5) & 1) << 8); }
constexpr int v_rd_off(int d0, int ks, int half) { return d0 * 512 + ks * 4096 + half * 2048; }
__device__ __forceinline__ int crow(int r, int hi) { return (r & 3) + 8 * (r >> 2) + 4 * hi; }
__device__ __forceinline__ unsigned cvtpk(float lo, float hi) { unsigned r; asm volatile("v_cvt_pk_bf16_f32 %0, %1, %2" : "=v"(r) : "v"(lo), "v"(hi)); return r; }
__device__ __forceinline__ bf16x8 load8(const bf16_t* p) { return *reinterpret_cast<const bf16x8*>(p); }

__device__ __forceinline__ void mask_tile(f32x16& p0, f32x16& p1, int dq, unsigned W) {
    const float NEG = -__builtin_inff();
#pragma unroll
    for (int r = 0; r < 16; ++r) {
        const int c = (r & 3) + 8 * (r >> 2);
        if ((unsigned)(dq - c) >= W) p0[r] = NEG;
        if ((unsigned)(dq - c - 32) >= W) p1[r] = NEG;
    }
}
template <int MODE> struct Cfg;
template <> struct Cfg<0> { static constexpr float SCALE = 0.08838834764831845f; static constexpr bool SK = true, ROPE = false, ALIBI = true; };
template <> struct Cfg<1> { static constexpr float SCALE = 0.07216878364870323f; static constexpr bool SK = false, ROPE = true, ALIBI = false; };
constexpr float THR = 8.f;

template <int MODE>
__device__ __forceinline__ void partialSM(f32x16& p0, f32x16& p1, float& m_reg, float& mn, float& alpha) {
    constexpr float SCALE = Cfg<MODE>::SCALE;
    float pmax = p0[0];
#pragma unroll
    for (int r = 1; r < 16; ++r) pmax = fmaxf(pmax, p0[r]);
#pragma unroll
    for (int r = 0; r < 16; ++r) pmax = fmaxf(pmax, p1[r]);
    { auto rr = __builtin_amdgcn_permlane32_swap(__float_as_uint(pmax), __float_as_uint(pmax), false, false);
      pmax = fmaxf(__uint_as_float(rr[0]), __uint_as_float(rr[1])); }
    constexpr float C2 = 1.4426950408889634f * SCALE;
    if (__builtin_expect(__all((pmax - m_reg) * SCALE <= THR), 1)) { mn = m_reg; alpha = 1.f; }
    else { mn = fmaxf(m_reg, pmax); alpha = __builtin_amdgcn_exp2f((m_reg - mn) * C2); m_reg = mn; }
    const float mnL = -mn * C2;
#pragma unroll
    for (int r = 0; r < 16; ++r) p0[r] = fmaf(p0[r], C2, mnL);
#pragma unroll
    for (int r = 0; r < 16; ++r) p1[r] = fmaf(p1[r], C2, mnL);
#pragma unroll
    for (int r = 0; r < 16; ++r) p0[r] = __builtin_amdgcn_exp2f(p0[r]);
}
__device__ __forceinline__ void finishSM(f32x16& p0, f32x16& p1, float alpha, float& l_reg, bf16x8& pa0, bf16x8& pa1, bf16x8& pa2, bf16x8& pa3) {
#pragma unroll
    for (int r = 0; r < 16; ++r) p1[r] = __builtin_amdgcn_exp2f(p1[r]);
    float ps = 0;
#pragma unroll
    for (int r = 0; r < 16; ++r) ps += p0[r];
#pragma unroll
    for (int r = 0; r < 16; ++r) ps += p1[r];
    { auto rr = __builtin_amdgcn_permlane32_swap(__float_as_uint(ps), __float_as_uint(ps), false, false);
      ps = __uint_as_float(rr[0]) + __uint_as_float(rr[1]); }
    l_reg = l_reg * alpha + ps;
#define PK4(P, B_, OUT) do { unsigned a0 = cvtpk(P[B_+0], P[B_+1]), a1 = cvtpk(P[B_+2], P[B_+3]);                          \
        unsigned b0 = cvtpk(P[B_+4], P[B_+5]), b1 = cvtpk(P[B_+6], P[B_+7]);                                             \
        auto r0 = __builtin_amdgcn_permlane32_swap(a0, b0, false, false); auto r1 = __builtin_amdgcn_permlane32_swap(a1, b1, false, false); \
        u32x4 w = {r0[0], r1[0], r0[1], r1[1]}; OUT = *reinterpret_cast<bf16x8*>(&w); } while (0)
    PK4(p0, 0, pa0); PK4(p0, 8, pa1); PK4(p1, 0, pa2); PK4(p1, 8, pa3);
#undef PK4
}
template <int KB, bool SK, bool ROPE>
__device__ __forceinline__ void qkt(f32x16& p0, f32x16& p1, const char* lds, int r32, int hi, const bf16x8* qr, const bf16x8* qrr, bool act) {
    if (SK && !act) { const float NEG = -__builtin_inff();
#pragma unroll
        for (int r = 0; r < 16; ++r) { p0[r] = NEG; p1[r] = NEG; } return; }
    p0 = f32x16{}; p1 = f32x16{};
    const char* kb[4];
#pragma unroll
    for (int dd = 0; dd < 4; ++dd) kb[dd] = lds + OFF_K + KB * SHM_K + KSWZ(r32, (dd * 16 + hi * 8) * 2);
#pragma unroll
    for (int d0 = 0; d0 < 8; ++d0) { const char* a = kb[d0 & 3] + (d0 >> 2) * 128;
        bf16x8 b0 = *reinterpret_cast<const bf16x8*>(a);
        bf16x8 b1 = *reinterpret_cast<const bf16x8*>(a + 32 * 256);
        p0 = __builtin_amdgcn_mfma_f32_32x32x16_bf16(b0, qr[d0], p0, 0, 0, 0);
        p1 = __builtin_amdgcn_mfma_f32_32x32x16_bf16(b1, qr[d0], p1, 0, 0, 0); }
    if constexpr (ROPE) {
#pragma unroll
        for (int d0 = 0; d0 < 4; ++d0) { const char* a = lds + OFF_KR + KB * SHM_KR + KRSWZ(r32, 2 * d0 + hi);
            bf16x8 b0 = *reinterpret_cast<const bf16x8*>(a);
            bf16x8 b1 = *reinterpret_cast<const bf16x8*>(a + 32 * 128);
            p0 = __builtin_amdgcn_mfma_f32_32x32x16_bf16(b0, qrr[d0], p0, 0, 0, 0);
            p1 = __builtin_amdgcn_mfma_f32_32x32x16_bf16(b1, qrr[d0], p1, 0, 0, 0); }
    }
}
template <int VB, bool SK>
__device__ __forceinline__ void pv_tile(f32x16* o, int vb0, bf16x8 pa0, bf16x8 pa1, bf16x8 pa2, bf16x8 pa3, bool act) {
    if (SK && !act) return;
#define TRRD(dst, off) asm volatile("ds_read_b64_tr_b16 %0, %1 offset:%2" : "=&v"(dst) : "v"(vb0), "i"(off) : "memory")
#define PV_D0(d0) do { s16x4 l0, l1, l2, l3, h0, h1, h2, h3; constexpr int b_ = OFF_V + VB * SHM_V + v_rd_off(d0, 0, 0); \
        TRRD(l0, b_); TRRD(h0, b_ + 2048); TRRD(l1, b_ + 4096); TRRD(h1, b_ + 6144); TRRD(l2, b_ + 8192); TRRD(h2, b_ + 10240); TRRD(l3, b_ + 12288); TRRD(h3, b_ + 14336); \
        asm volatile("s_waitcnt lgkmcnt(0)" ::: "memory"); SBAR();   \
        o[d0] = __builtin_amdgcn_mfma_f32_32x32x16_bf16(pa0, (bf16x8){l0[0], l0[1], l0[2], l0[3], h0[0], h0[1], h0[2], h0[3]}, o[d0], 0, 0, 0);   \
        o[d0] = __builtin_amdgcn_mfma_f32_32x32x16_bf16(pa1, (bf16x8){l1[0], l1[1], l1[2], l1[3], h1[0], h1[1], h1[2], h1[3]}, o[d0], 0, 0, 0);   \
        o[d0] = __builtin_amdgcn_mfma_f32_32x32x16_bf16(pa2, (bf16x8){l2[0], l2[1], l2[2], l2[3], h2[0], h2[1], h2[2], h2[3]}, o[d0], 0, 0, 0);   \
        o[d0] = __builtin_amdgcn_mfma_f32_32x32x16_bf16(pa3, (bf16x8){l3[0], l3[1], l3[2], l3[3], h3[0], h3[1], h3[2], h3[3]}, o[d0], 0, 0, 0); } while (0)
    PV_D0(0); PV_D0(1); PV_D0(2); PV_D0(3);
#undef PV_D0
#undef TRRD
}

struct BlockRef {
    const bf16_t* Q; const bf16_t* K; const bf16_t* V; bf16_t* O;
    const bf16_t* QR; const bf16_t* KR;
    const float* POS; float* LSE;
    int qs, ks, vs, os, ps, ls;
    int P0, skv, W; float slopeS;
};
template <int MODE> struct Seam {
    bf16x8 qr[8]; bf16x8 qrr[4];
    bf16x8 st_v0, st_v1, st_k0, st_k1, st_kr; float st_pos;
};
__device__ __forceinline__ int swa_jlo(int P0, int W) { const int lowk = P0 - W + 1; return lowk > 0 ? lowk / KVBLK : 0; }
#define VMW() asm volatile("s_waitcnt vmcnt(0)" ::: "memory")
#define VMWN(n) asm volatile("s_waitcnt vmcnt(%0)" :: "i"(n) : "memory")
__device__ __forceinline__ bf16x8 gld8(const bf16_t* base, size_t uoff, unsigned lboff) { return *reinterpret_cast<const bf16x8*>((const char*)(base + uoff) + lboff); }
#define SLOAD_H(R, k0) do { const unsigned lv0_ = (unsigned)(sr * (R).vs + sc) * 2u, lv1_ = (unsigned)((32 + sr) * (R).vs + sc) * 2u;                                   \
                         const unsigned lk0_ = (unsigned)(sr * (R).ks + sc) * 2u, lk1_ = (unsigned)((32 + sr) * (R).ks + sc) * 2u;                                    \
                         S.st_v0 = gld8((R).V, (size_t)(k0) * (R).vs, lv0_); S.st_v1 = gld8((R).V, (size_t)(k0) * (R).vs, lv1_);                                          \
                         S.st_k0 = gld8((R).K, (size_t)(k0) * (R).ks, lk0_); S.st_k1 = gld8((R).K, (size_t)(k0) * (R).ks, lk1_);                                          \
                         if constexpr (C::ROPE) S.st_kr = gld8((R).KR, (size_t)(k0) * 64, (unsigned)(krr * 64 + krc * 8) * 2u);                                          \
                         if constexpr (C::ALIBI) { if (tid < 64) S.st_pos = (R).POS[(size_t)((k0) + tid) * (R).ps]; } } while (0)
#define SWRITE_HK(bf) do { *(bf16x8*)(lds + OFF_K + (bf) * SHM_K + kws) = S.st_k0; *(bf16x8*)(lds + OFF_K + (bf) * SHM_K + kws + 32 * 256) = S.st_k1;                 \
                         if constexpr (C::ROPE) *(bf16x8*)(lds + OFF_KR + (bf) * SHM_KR + krw) = S.st_kr;                                                                \
                         if constexpr (C::ALIBI) { if (tid < 64) *(float*)(lds + OFF_POS + (bf) * 256 + tid * 4) = S.st_pos; } } while (0)
#define SWRITE_HV(bf) do { *(bf16x8*)(lds + OFF_V + (bf) * SHM_V + vst0) = S.st_v0; *(bf16x8*)(lds + OFF_V + (bf) * SHM_V + vst1) = S.st_v1; } while (0)
#define SWRITE_H(bf) do { SWRITE_HV(bf); SWRITE_HK(bf); } while (0)
#define QLOAD(R) do { const size_t qu_ = (size_t)((R).P0 + wid * QBLK) * (R).qs; const unsigned ql_ = (unsigned)(r32 * (R).qs + hi * 8) * 2u;                          \
                      _Pragma("unroll") for (int d0 = 0; d0 < 8; ++d0) S.qr[d0] = gld8((R).Q, qu_ + d0 * 16, ql_);                                                       \
                      if constexpr (C::ROPE) { _Pragma("unroll") for (int d0 = 0; d0 < 4; ++d0) S.qrr[d0] = gld8((R).QR, qu_ + d0 * 16, ql_); } } while (0)

template <int MODE>
__device__ __forceinline__ void attn_prime(const BlockRef& cur, char* lds, Seam<MODE>& S) {
    using C = Cfg<MODE>;
    const int tid = threadIdx.x, wid = __builtin_amdgcn_readfirstlane(tid >> 6), lane = tid & 63, r32 = lane & 31, hi = lane >> 5;
    const int sr = tid >> 4, sc = (tid & 15) * 8, kws = KSWZ(sr, sc * 2);
    const int krr = tid >> 3, krc = tid & 7, krw = KRSWZ(krr, krc);
    const int kb0 = swa_jlo(cur.P0, cur.W) * KVBLK;
    QLOAD(cur);
    SLOAD_H(cur, kb0); VMW(); SWRITE_HK(0);
    __syncthreads();
}
template <int MODE>
__device__ __forceinline__ void attn_block(const BlockRef& cur, const BlockRef& nxt, char* lds, Seam<MODE>& S) {
    using C = Cfg<MODE>;
    constexpr bool SK = C::SK; constexpr float SCALE = C::SCALE;
    const int tid = threadIdx.x, wid = __builtin_amdgcn_readfirstlane(tid >> 6), lane = tid & 63, r32 = lane & 31, hi = lane >> 5;
    const int W = cur.W;
    const int j_lo = swa_jlo(cur.P0, W);
    int j_hi = (cur.P0 + QB - 1) / KVBLK + 1; if (j_hi > cur.skv / KVBLK) j_hi = cur.skv / KVBLK;
    const int NT = j_hi - j_lo;
    const int kbn = swa_jlo(nxt.P0, nxt.W) * KVBLK;
    const int qlo = cur.P0 + wid * QBLK, qm = qlo + r32 - 4 * hi;
    float* ws = (float*)(lds + OFF_WS) + wid * 64; float* li_l = ws, * al_l = ws + 32;
    float m_reg = -1e30f, l_reg = 0; f32x16 o[4] = {};
    const int sr = tid >> 4, sc = (tid & 15) * 8, vst0 = v_st(sr, sc), vst1 = v_st(32 + sr, sc), kws = KSWZ(sr, sc * 2);
    const int krr = tid >> 3, krc = tid & 7, krw = KRSWZ(krr, krc);
    const int vb0 = (int)(uintptr_t)(lds) + v_rd_base(lane);
    float posq = 0.f;
    if constexpr (C::ALIBI) posq = cur.POS[(size_t)(qlo + r32) * cur.ps];
    const float slopeS = cur.slopeS;
#define RESC(a) do { if (__any((a) < 1.f)) { if (hi == 0) al_l[r32] = (a); asm volatile("s_waitcnt lgkmcnt(0)" ::: "memory");              \
                     _Pragma("unroll") for (int d_ = 0; d_ < 4; ++d_) _Pragma("unroll") for (int r = 0; r < 16; ++r) o[d_][r] *= al_l[crow(r, hi)]; } } while (0)
#define KBASE(t) ((j_lo + (t)) * KVBLK)
#define ACT(t) (KBASE(t) <= qlo + QBLK - 1 && KBASE(t) + KVBLK - 1 >= qlo - W + 1)
#define MASKT(P0_, P1_, t, BUF) do { const int kb_ = KBASE(t);                                                                               \
        if constexpr (C::ALIBI) { if (!SK || ACT(t)) { const f32x4* pp = (const f32x4*)(lds + OFF_POS + (BUF) * 256) + hi;                 \
            _Pragma("unroll") for (int g_ = 0; g_ < 4; ++g_) { const f32x4 k0_ = pp[2 * g_], k1_ = pp[2 * g_ + 8];                           \
                _Pragma("unroll") for (int e_ = 0; e_ < 4; ++e_) { P0_[4 * g_ + e_] = fmaf(-slopeS, fabsf(posq - k0_[e_]), P0_[4 * g_ + e_]); \
                                                                   P1_[4 * g_ + e_] = fmaf(-slopeS, fabsf(posq - k1_[e_]), P1_[4 * g_ + e_]); } } } } \
        if ((!SK || ACT(t)) && (kb_ + KVBLK - 1 > qlo || kb_ <= qlo + QBLK - 1 - W)) mask_tile(P0_, P1_, qm - kb_, (unsigned)W); } while (0)
    f32x16 p0, p1; float mn, al; bf16x8 pa0, pa1, pa2, pa3;
    SWRITE_HV(0); SBAR();
    if (NT > 1) { SLOAD_H(cur, KBASE(1)); }
    __syncthreads();
#define STEP(t, BUF) do {                                                                                                      \
        SBAR(); qkt<BUF, SK, C::ROPE>(p0, p1, lds, r32, hi, S.qr, S.qrr, ACT(t));                                              \
        MASKT(p0, p1, (t), BUF); partialSM<MODE>(p0, p1, m_reg, mn, al); RESC(al);                                             \
        finishSM(p0, p1, al, l_reg, pa0, pa1, pa2, pa3); SBAR();                                                               \
        pv_tile<BUF, SK>(o, vb0, pa0, pa1, pa2, pa3, ACT(t)); SBAR();                                                          \
        if ((t) + 1 < NT) { VMW(); SWRITE_H((BUF) ^ 1); }                                                                      \
        __syncthreads();                                                                                                       \
        if ((t) + 2 < NT) { SLOAD_H(cur, KBASE((t) + 2)); } SBAR(); } while (0)
    for (int t = 0; t + 1 < NT; t += 2) { STEP(t, 0); STEP(t + 1, 1); }
    if (NT & 1) { STEP(NT - 1, 0); }
    SLOAD_H(nxt, kbn); SBAR();
    QLOAD(nxt);
    SBAR();
    if (hi == 0) li_l[r32] = l_reg; asm volatile("s_waitcnt lgkmcnt(0)" ::: "memory");
    if constexpr (C::ALIBI) { if (hi == 0) cur.LSE[(size_t)(qlo + r32) * cur.ls] = m_reg * SCALE + __logf(l_reg); }
    float rli[16];
#pragma unroll
    for (int r = 0; r < 16; ++r) rli[r] = __builtin_amdgcn_rcpf(li_l[crow(r, hi)]);
    bf16_t* Ow = cur.O + (size_t)qlo * cur.os;
    const unsigned ol_ = (unsigned)(4 * hi * cur.os + r32) * 2u;
#pragma unroll
    for (int r = 0; r < 16; ++r) { const size_t ou_ = (size_t)((r & 3) + 8 * (r >> 2)) * cur.os;
#pragma unroll
        for (int d0 = 0; d0 < 4; ++d0) { const float v = o[d0][r] * rli[r];
            const float vn = __shfl_xor(v, 1);
            if ((r32 & 1) == 0) *(unsigned*)((char*)(Ow + ou_ + d0 * 32) + ol_) = cvtpk(v, vn); } }
    VMW(); SWRITE_HK(0);
    __syncthreads();
#undef RESC
#undef KBASE
#undef ACT
#undef MASKT
#undef STEP
}
#undef VMW
#undef VMWN
#undef SLOAD_H
#undef SWRITE_HK
#undef SWRITE_HV
#undef SWRITE_H
#undef QLOAD
}
constexpr size_t MiB = 1u << 20;
constexpr size_t WS_CTL = 0, CTL_ZERO_BYTES = 1 * MiB;
constexpr size_t WS_SM = 1 * MiB;
constexpr size_t WS_MODV = WS_SM;
constexpr size_t WS_RQ = WS_SM + 128 * 1024, WS_RKV = WS_SM + 192 * 1024, WS_POSF = WS_SM + 256 * 1024, WS_CNT = WS_SM + 320 * 1024, WS_TILEE = WS_SM + 384 * 1024;
constexpr size_t WS_MODP = 2 * MiB;
constexpr size_t WS_COS = 4 * MiB, WS_SIN = 6 * MiB, WS_KR = 8 * MiB, WS_LOGIT = 10 * MiB, WS_EIDX = 14 * MiB, WS_EW = 14 * MiB + 512 * 1024;
constexpr size_t WS_STOK = 15 * MiB, WS_SDST = 16 * MiB, WS_SW = 17 * MiB, WS_LSE = 18 * MiB;
constexpr size_t WS_WG2 = 20 * MiB;
constexpr size_t WS_WIN = 150 * MiB, WS_WO = 166 * MiB, WS_WUQ = 174 * MiB, WS_WUKV = 176 * MiB, WS_WR = 177 * MiB;
constexpr size_t WS_WG1 = 178 * MiB;
constexpr size_t WS_H = 438 * MiB;
constexpr size_t WS_PROJ = 503 * MiB;
constexpr size_t WS_MIX = WS_PROJ;
constexpr size_t WS_QM = 631 * MiB, WS_KV = 679 * MiB, WS_OSWA = 743 * MiB, WS_OMLA = 839 * MiB;
constexpr size_t WS_YS = WS_WG1;
constexpr size_t WS_ACT = 700 * MiB;
constexpr size_t WS_END = 871 * MiB;
static_assert(WS_YS + (size_t)S_ * 8 * DM * 2 <= WS_ACT && WS_ACT + (size_t)MAX_SLOTS * 512 * 2 <= WS_END, "ws map");
static_assert(WS_WG2 + (size_t)NE1 * 2048 * 512 * 2 <= WS_WIN && WS_WG1 + (size_t)NE1 * 1024 * 2048 * 2 <= WS_H && WS_H + (size_t)(S_ + 256) * DM * 2 <= WS_PROJ, "ws map 2");
constexpr int CW_TMO = 0, CW_NT = 16, CW_BAR = 4096;

constexpr int RING_BYTES = 131072, LDSCTL_OFF = RING_BYTES, MISC_OFF = LDSCTL_OFF + 320, TILE_OFF = LDSCTL_OFF + 1024, LDS_BYTES = 147456;
static_assert(TILE_OFF + MAX_TILES * 4 <= LDS_BYTES, "lds map");

#define XB_TMO      128
#define XB_XCNT(j)  (256  + 64 * (j))
#define XB_XSUB(j)  (1280 + 64 * (j))
#define XB_XGEN(j)  (2304 + 64 * (j))
#define XB_TOP      3328
#define XB_TOPGEN   3392
#define XCD_BAR_WORDS 3456
#define XB_SPIN_CAP (1u << 18)
__device__ __forceinline__ unsigned xb_ld(unsigned* p)              { return __hip_atomic_load(p, __ATOMIC_RELAXED, __HIP_MEMORY_SCOPE_AGENT); }
__device__ __forceinline__ unsigned xb_add(unsigned* p, unsigned v) { return __hip_atomic_fetch_add(p, v, __ATOMIC_RELAXED, __HIP_MEMORY_SCOPE_AGENT); }
__device__ __forceinline__ unsigned xb_xcc_id() { return (unsigned)__builtin_amdgcn_s_getreg((3 << 11) | 20) & 0xFu; }
#define XB_SPIN(cond, bar) do { unsigned _sp = 0; while (cond) { __builtin_amdgcn_s_sleep(1); \
    if ((++_sp & 255u) == 0u) { if (xb_ld(&(bar)[XB_TMO])) break; if (_sp > XB_SPIN_CAP) { atomicAdd(&(bar)[XB_TMO], 1u); break; } } } } while (0)
struct XcdBarrier { unsigned* bar; unsigned x; volatile LAS unsigned* st; };
__device__ __forceinline__ XcdBarrier xcd_barrier_post(unsigned* bar, volatile LAS unsigned* st) {
    XcdBarrier b; b.bar = bar; b.x = xb_xcc_id(); b.st = st;
    if (threadIdx.x == 0) (void)xb_add(&bar[XB_XCNT(b.x)], 1u);
    return b;
}
__device__ __forceinline__ void xcd_barrier_complete(unsigned* bar, unsigned x, unsigned& nloc, unsigned& nx) {
    const unsigned G = gridDim.x * gridDim.y * gridDim.z;
    unsigned sum, cnt, mine, sp = 0u;
    for (;;) {
        sum = 0u; cnt = 0u; mine = 0u;
#pragma unroll
        for (unsigned j = 0; j < 16; ++j) { const unsigned c = xb_ld(&bar[XB_XCNT(j)]); sum += c; cnt += (c > 0u) ? 1u : 0u; mine = (j == x) ? c : mine; }
        if (sum == G) break;
        __builtin_amdgcn_s_sleep(1);
        if ((++sp & 255u) == 0u) { if (xb_ld(&bar[XB_TMO])) break; if (sp > XB_SPIN_CAP) { atomicAdd(&bar[XB_TMO], 1u); break; } }
    }
    nloc = mine > 0u ? mine : 1u; nx = cnt > 0u ? cnt : 1u;
}
__device__ __forceinline__ void xcd_barrier(const XcdBarrier& b) {
    asm volatile("s_waitcnt vmcnt(0)" ::: "memory");
    __syncthreads();
    if (threadIdx.x == 0) {
        unsigned* bar = b.bar;
        __builtin_amdgcn_s_waitcnt(0);
        unsigned nloc = b.st[0], nx = b.st[1];
        if (nloc == 0u) { xcd_barrier_complete(bar, b.x, nloc, nx); b.st[0] = nloc; b.st[1] = nx; }
        const unsigned old = xb_add(&bar[XB_XSUB(b.x)], 1u);
        const unsigned gen = old / nloc;
        if (old + 1u == (gen + 1u) * nloc) {
            __builtin_amdgcn_fence(__ATOMIC_RELEASE, "agent");
            asm volatile("s_waitcnt vmcnt(0)" ::: "memory");
            const unsigned og = xb_add(&bar[XB_TOP], 1u);
            const unsigned tg = og / nx;
            if (og + 1u == (tg + 1u) * nx) xb_add(&bar[XB_TOPGEN], 1u);
            else XB_SPIN(xb_ld(&bar[XB_TOPGEN]) == tg, bar);
            __builtin_amdgcn_fence(__ATOMIC_ACQUIRE, "agent");
            xb_add(&bar[XB_XGEN(b.x)], 1u);
            asm volatile("s_waitcnt vmcnt(0)" ::: "memory");
        } else {
            XB_SPIN(xb_ld(&bar[XB_XGEN(b.x)]) == gen, bar);
            __builtin_amdgcn_fence(__ATOMIC_ACQUIRE, "agent");
            asm volatile("s_waitcnt vmcnt(0)" ::: "memory");
        }
    }
    __syncthreads();
}

constexpr int NWAVES = 8;
struct Frame {
    LAS unsigned char* lds; char* ldsg;
    volatile LAS unsigned* MISC;
    unsigned* ctl;
    int tid, lane, wave, G, bid;
    unsigned char* ws;
    const float *x, *c, *norm_attn_g, *w_ada, *b_ada, *w_in, *g_q, *w_uq, *g_kv, *w_ukv, *g_out_swa, *g_out_mla, *w_o, *norm_ffn_g, *w_router, *router_bias;
    const float *w_exp_gate, *w_exp_up, *w_exp_down, *w_sh_gate, *w_sh_up, *w_sh_down, *final_norm_g;
    const int* positions;
    float* out;
};
#define LDS_WAIT() asm volatile("s_waitcnt lgkmcnt(0)" ::: "memory")
#define WSP(T, off) ((T*)(F.ws + (off)))

__device__ __forceinline__ void transpose_item(const float* W, int ldw, int k0, bf16_t* dst, int Kd, const float* kscale, bool zero, LAS float* scr, int lane) {
    if (!zero) {
#pragma unroll 8
        for (int i = 0; i < 32; ++i) { const int kk = 2 * i + (lane >> 5); float v = W[(size_t)(k0 + kk) * ldw + (lane & 31)]; if (kscale) v *= kscale[k0 + kk]; scr[kk * 33 + (lane & 31)] = v; }
    }
    LDS_WAIT(); asm volatile("" ::: "memory");
    const int c = lane & 7;
#pragma unroll
    for (int j = 0; j < 4; ++j) { const int n = (lane >> 3) + 8 * j; const LAS float* s = scr + (8 * c) * 33 + n;
        u32x4 o;
        if (zero) { o = (u32x4){0u, 0u, 0u, 0u}; }
        else { o.x = pk2(s[0 * 33], s[1 * 33]); o.y = pk2(s[2 * 33], s[3 * 33]); o.z = pk2(s[4 * 33], s[5 * 33]); o.w = pk2(s[6 * 33], s[7 * 33]); }
        *(u32x4*)(dst + (size_t)n * Kd + k0 + 8 * c) = o; }
    LDS_WAIT(); asm volatile("" ::: "memory");
}
constexpr int I_WIN = 32 * 128, I_WUQ = 8 * 48, I_WUKV = 4 * 64, I_WO = 32 * 64, I_WR = 32 * 8, I_G1 = NE1 * 1024, I_G2 = NE1 * 512;
constexpr int I_TOTAL = I_WIN + I_WUQ + I_WUKV + I_WO + I_WR + I_G1 + I_G2;
constexpr int GEMV_ITEMS = 48 * 32;

__device__ __forceinline__ void convert_item(Frame& F, int it, LAS float* scr) {
    int r = it; const int lane = F.lane;
    if (r < I_WIN) { const int kb = r / 128, nb = r % 128; transpose_item(F.w_in + nb * 32, 3904, kb * 64, WSP(bf16_t, WS_WIN) + (size_t)nb * 32 * 2048, 2048, nullptr, nb >= 122, scr, lane); return; } r -= I_WIN;
    if (r < I_WUQ) { const int kb = r / 48, nb = r % 48, pn = nb >> 3, p0 = (nb & 7) * 32; int col;
        if (pn < 4) col = (2 * pn + (p0 >> 7)) * 192 + (p0 & 127);
        else if (p0 < 128) col = (4 * (pn - 4) + (p0 >> 5)) * 192 + 128;
        else col = (4 * (pn - 4) + ((p0 - 128) >> 5)) * 192 + 160;
        transpose_item(F.w_uq + col, 1536, kb * 64, WSP(bf16_t, WS_WUQ) + (size_t)nb * 32 * 512, 512, F.g_q, false, scr, lane); return; } r -= I_WUQ;
    if (r < I_WUKV) { const int kb = r / 64, nb = r % 64; transpose_item(F.w_ukv + nb * 32, 2048, kb * 64, WSP(bf16_t, WS_WUKV) + (size_t)nb * 32 * 256, 256, F.g_kv, false, scr, lane); return; } r -= I_WUKV;
    if (r < I_WO) { const int kb = r / 64, nb = r % 64; transpose_item(F.w_o + nb * 32, 2048, kb * 64, WSP(bf16_t, WS_WO) + (size_t)nb * 32 * 2048, 2048, nullptr, false, scr, lane); return; } r -= I_WO;
    if (r < I_WR) { const int kb = r / 8, nb = r % 8; transpose_item(F.w_router + (nb < 2 ? nb * 32 : 0), 64, kb * 64, WSP(bf16_t, WS_WR) + (size_t)nb * 32 * 2048, 2048, nullptr, nb >= 2, scr, lane); return; } r -= I_WR;
    if (r < I_G1) { const int e = r >> 10, r2 = r & 1023, kb = r2 >> 5, nb = r2 & 31, pn = nb >> 3, p0 = (nb & 7) * 32;
        const float* src = (p0 < 128) ? (e < NEXP ? F.w_exp_gate + (size_t)e * 2048 * 512 : F.w_sh_gate) + 128 * pn + p0
                                      : (e < NEXP ? F.w_exp_up + (size_t)e * 2048 * 512 : F.w_sh_up) + 128 * pn + (p0 - 128);
        transpose_item(src, 512, kb * 64, WSP(bf16_t, WS_WG1) + ((size_t)e * 1024 + nb * 32) * 2048, 2048, nullptr, false, scr, lane); return; } r -= I_G1;
    { const int e = r >> 9, r2 = r & 511, kb = r2 >> 6, nb = r2 & 63;
        const float* src = (e < NEXP ? F.w_exp_down + (size_t)e * 512 * 2048 : F.w_sh_down) + nb * 32;
        transpose_item(src, 2048, kb * 64, WSP(bf16_t, WS_WG2) + ((size_t)e * 2048 + nb * 32) * 512, 512, nullptr, false, scr, lane); }
}
__device__ __forceinline__ float silu_f(float v) { return v / (1.f + __expf(-v)); }
__device__ __forceinline__ void p0_prologue(Frame& F) {
    LAS float* scr = (LAS float*)(F.lds + F.wave * 16384);
    const int gw = F.bid * NWAVES + F.wave, NGW = F.G * NWAVES;
    for (int it = gw; it < GEMV_ITEMS; it += NGW) {
        const int ch = it % 48, kr = it / 48, col = ch * 256 + F.lane * 4;
        f32x4 a = {0.f, 0.f, 0.f, 0.f};
#pragma unroll 8
        for (int k = 0; k < 64; ++k) { const int kk = kr * 64 + k; const float s = silu_f(F.c[kk]); a += s * *(const f32x4*)(F.w_ada + (size_t)kk * 12288 + col); }
        *(f32x4*)(WSP(float, WS_MODP) + (size_t)kr * 12288 + col) = a;
    }
    for (int it = gw; it < I_TOTAL; it += NGW) convert_item(F, it, scr);
}
__device__ __forceinline__ void p1_mod(Frame& F) {
    const int g = F.bid * 512 + F.tid, NG = F.G * 512;
    for (int i = g; i < 12288; i += NG) {
        float v = F.b_ada[i];
        for (int kr = 0; kr < 32; ++kr) v += WSP(float, WS_MODP)[(size_t)kr * 12288 + i];
        const int chunk = i >> 11, col = i & 2047; float* mv = WSP(float, WS_MODV);
        if (chunk == 0) mv[1 * 2048 + col] = v;
        else if (chunk == 1) mv[0 * 2048 + col] = F.norm_attn_g[col] * (1.f + v);
        else if (chunk == 2) mv[2 * 2048 + col] = v;
        else if (chunk == 3) mv[4 * 2048 + col] = v;
        else if (chunk == 4) mv[3 * 2048 + col] = F.norm_ffn_g[col] * (1.f + v);
        else mv[5 * 2048 + col] = v;
    }
    for (int i = g; i < S_; i += NG) WSP(float, WS_POSF)[i] = (float)F.positions[i];
    for (int i = g; i < 1024; i += NG) WSP(unsigned, WS_H)[(size_t)S_ * 1024 + i] = 0u;
}
__device__ __forceinline__ void norm_mod_row(const float* xrow, const float* A, const float* B, bf16_t* orow, int lane) {
    const f32x4* xr = (const f32x4*)xrow + lane;
    f32x4 v[8]; float s = 0.f;
#pragma unroll
    for (int j = 0; j < 8; ++j) { v[j] = xr[64 * j]; s += (v[j].x * v[j].x + v[j].y * v[j].y) + (v[j].z * v[j].z + v[j].w * v[j].w); }
    const float rstd = 1.f / sqrtf(wave_sum(s) * (1.f / DM) + EPS_);
    unsigned long long* o8 = (unsigned long long*)orow + lane;
#pragma unroll
    for (int j = 0; j < 8; ++j) { const f32x4 a = ((const f32x4*)A)[lane + 64 * j], b = ((const f32x4*)B)[lane + 64 * j]; const f32x4 h = v[j] * rstd * a + b;
        o8[64 * j] = (unsigned long long)pk2(h.x, h.y) | ((unsigned long long)pk2(h.z, h.w) << 32); }
}
__device__ __forceinline__ void p3_prep(Frame& F) {
    const int gw = F.bid * NWAVES + F.wave, NGW = F.G * NWAVES, lane = F.lane;
    for (int t = gw; t < S_; t += NGW) {
        const bf16_t* pr = WSP(bf16_t, WS_PROJ) + (size_t)t * D_INP;
        { const u32x4 w = *(const u32x4*)(pr + 3072 + 8 * lane); float s = 0.f;
#pragma unroll
          for (int i = 0; i < 4; ++i) { const float a = bf_lo(w[i]), b = bf_hi(w[i]); s += a * a + b * b; }
          s = wave_sum(s); if (lane == 0) WSP(float, WS_RQ)[t] = 1.f / sqrtf(s * (1.f / 512.f) + EPS_); }
        { float s = 0.f; if (lane < 32) { const u32x4 w = *(const u32x4*)(pr + 3584 + 8 * lane);
#pragma unroll
              for (int i = 0; i < 4; ++i) { const float a = bf_lo(w[i]), b = bf_hi(w[i]); s += a * a + b * b; } }
          s = wave_sum(s); if (lane == 0) WSP(float, WS_RKV)[t] = 1.f / sqrtf(s * (1.f / 256.f) + EPS_); }
        if (lane < 32) {
            const float x1 = __builtin_bit_cast(float, (unsigned)pr[3840 + lane] << 16), x2 = __builtin_bit_cast(float, (unsigned)pr[3872 + lane] << 16);
            const float inv = powf(10000.f, -(float)lane / 32.f); const float ang = (float)F.positions[t] * inv;
            float sn, cs; sincosf(ang, &sn, &cs);
            WSP(float, WS_COS)[(size_t)t * 32 + lane] = cs; WSP(float, WS_SIN)[(size_t)t * 32 + lane] = sn;
            bf16_t* kr = WSP(bf16_t, WS_KR) + (size_t)t * 64;
            kr[lane] = (bf16_t)f2bf(x1 * cs - x2 * sn); kr[32 + lane] = (bf16_t)f2bf(x2 * cs + x1 * sn);
        }
    }
}
__device__ __forceinline__ void p6_mix(Frame& F) {
    const int gw = F.bid * NWAVES + F.wave, NGW = F.G * NWAVES, lane = F.lane;
    for (int t = gw; t < S_; t += NGW) {
        const int h = lane >> 3; float ls[3], mx = -1e30f;
#pragma unroll
        for (int p = 0; p < 3; ++p) { ls[p] = WSP(float, WS_LSE)[((size_t)p * S_ + t) * 8 + h]; mx = fmaxf(mx, ls[p]); }
        float al[3], sa = 0.f;
#pragma unroll
        for (int p = 0; p < 3; ++p) { al[p] = __expf(ls[p] - mx); sa += al[p]; }
        const float isa = 1.f / sa; float o[16];
#pragma unroll
        for (int i = 0; i < 16; ++i) o[i] = 0.f;
#pragma unroll
        for (int p = 0; p < 3; ++p) { const float a = al[p] * isa; const u32x4* src = (const u32x4*)(WSP(bf16_t, WS_OSWA) + ((size_t)p * S_ + t) * 1024 + 16 * lane);
#pragma unroll
            for (int q = 0; q < 2; ++q) { const u32x4 w = src[q];
#pragma unroll
                for (int i = 0; i < 4; ++i) { o[q * 8 + 2 * i] += a * bf_lo(w[i]); o[q * 8 + 2 * i + 1] += a * bf_hi(w[i]); } } }
        float ss = 0.f;
#pragma unroll
        for (int i = 0; i < 16; ++i) ss += o[i] * o[i];
        float rstd = 1.f / sqrtf(wave_sum(ss) * (1.f / 1024.f) + EPS_);
        bf16_t* mrow = WSP(bf16_t, WS_MIX) + (size_t)t * DM;
        { u32x4 w0, w1; const float* gg = F.g_out_swa + 16 * lane;
          w0.x = pk2(o[0] * rstd * gg[0], o[1] * rstd * gg[1]); w0.y = pk2(o[2] * rstd * gg[2], o[3] * rstd * gg[3]); w0.z = pk2(o[4] * rstd * gg[4], o[5] * rstd * gg[5]); w0.w = pk2(o[6] * rstd * gg[6], o[7] * rstd * gg[7]);
          w1.x = pk2(o[8] * rstd * gg[8], o[9] * rstd * gg[9]); w1.y = pk2(o[10] * rstd * gg[10], o[11] * rstd * gg[11]); w1.z = pk2(o[12] * rstd * gg[12], o[13] * rstd * gg[13]); w1.w = pk2(o[14] * rstd * gg[14], o[15] * rstd * gg[15]);
          *(u32x4*)(mrow + 16 * lane) = w0; *(u32x4*)(mrow + 16 * lane + 8) = w1; }
        { const u32x4* src = (const u32x4*)(WSP(bf16_t, WS_OMLA) + (size_t)t * 1024 + 16 * lane);
#pragma unroll
          for (int q = 0; q < 2; ++q) { const u32x4 w = src[q];
#pragma unroll
              for (int i = 0; i < 4; ++i) { o[q * 8 + 2 * i] = bf_lo(w[i]); o[q * 8 + 2 * i + 1] = bf_hi(w[i]); } } }
        ss = 0.f;
#pragma unroll
        for (int i = 0; i < 16; ++i) ss += o[i] * o[i];
        rstd = 1.f / sqrtf(wave_sum(ss) * (1.f / 1024.f) + EPS_);
        { u32x4 w0, w1; const float* gg = F.g_out_mla + 16 * lane;
          w0.x = pk2(o[0] * rstd * gg[0], o[1] * rstd * gg[1]); w0.y = pk2(o[2] * rstd * gg[2], o[3] * rstd * gg[3]); w0.z = pk2(o[4] * rstd * gg[4], o[5] * rstd * gg[5]); w0.w = pk2(o[6] * rstd * gg[6], o[7] * rstd * gg[7]);
          w1.x = pk2(o[8] * rstd * gg[8], o[9] * rstd * gg[9]); w1.y = pk2(o[10] * rstd * gg[10], o[11] * rstd * gg[11]); w1.z = pk2(o[12] * rstd * gg[12], o[13] * rstd * gg[13]); w1.w = pk2(o[14] * rstd * gg[14], o[15] * rstd * gg[15]);
          *(u32x4*)(mrow + 1024 + 16 * lane) = w0; *(u32x4*)(mrow + 1024 + 16 * lane + 8) = w1; }
    }
}
__device__ __forceinline__ void p10_route(Frame& F) {
    LAS int* hist = (LAS int*)F.lds;
    if (F.tid < 64) hist[F.tid] = 0;
    __syncthreads();
    const int lane = F.lane;
    const float rb = F.router_bias[lane];
    for (int q = 0; q < 8; ++q) {
        const int t = F.bid * 64 + F.wave * 8 + q;
        const float logit = WSP(float, WS_LOGIT)[(size_t)t * 64 + lane];
        const float score = 1.f / (1.f + __expf(-logit)), choice = score + rb;
        float m1 = choice; m1 = fmaxf(m1, __shfl_xor(m1, 1)); m1 = fmaxf(m1, __shfl_xor(m1, 2)); m1 = fmaxf(m1, __shfl_xor(m1, 4));
        int cand = (choice == m1) ? (lane & 7) : 8; cand = min(cand, __shfl_xor(cand, 1)); cand = min(cand, __shfl_xor(cand, 2)); cand = min(cand, __shfl_xor(cand, 4));
        float m2 = ((lane & 7) == cand) ? -__builtin_inff() : choice; m2 = fmaxf(m2, __shfl_xor(m2, 1)); m2 = fmaxf(m2, __shfl_xor(m2, 2)); m2 = fmaxf(m2, __shfl_xor(m2, 4));
        const float gs = m1 + m2; const int g = lane >> 3; int rank = 0;
#pragma unroll
        for (int gg = 0; gg < 8; ++gg) { const float s = __shfl(gs, gg * 8); rank += (s > gs || (s == gs && gg < g)) ? 1 : 0; }
        const float masked = (rank < 4) ? choice : -1e30f;
        int r = 0;
        for (int e2 = 0; e2 < 64; ++e2) { const float v = __shfl(masked, e2); r += (v > masked || (v == masked && e2 < lane)) ? 1 : 0; }
        const bool sel = r < 8;
        const float ssum = wave_sum(sel ? score : 0.f);
        if (sel) { WSP(int, WS_EIDX)[(size_t)t * 8 + r] = lane; WSP(float, WS_EW)[(size_t)t * 8 + r] = score / ssum * 2.5f; atomicAdd((int*)&hist[lane], 1); }
    }
    __syncthreads();
    if (F.tid < 64) WSP(int, WS_CNT)[F.bid * 64 + F.tid] = hist[F.tid];
    __syncthreads();
}
__device__ __forceinline__ void p11_slots(Frame& F) {
    LAS int* tot = (LAS int*)F.lds;
    LAS int* pre = tot + 512;
    LAS int* total = pre + 512;
    LAS int* mypre = total + 80;
    LAS int* cursor = mypre + 64;
    LAS int* base = cursor + 64;
    LAS int* ntl = base + 80;
    const int tid = F.tid, b = F.bid;
    { const int e = tid & 63, part = tid >> 6; int sa = 0, sp = 0;
      for (int bb = part * 32; bb < part * 32 + 32; ++bb) { const int c = WSP(int, WS_CNT)[bb * 64 + e]; sa += c; if (bb < b) sp += c; }
      tot[part * 64 + e] = sa; pre[part * 64 + e] = sp; }
    __syncthreads();
    if (tid < 64) { int sa = 0, sp = 0;
        for (int p = 0; p < 8; ++p) { sa += tot[p * 64 + tid]; sp += pre[p * 64 + tid]; }
        total[tid] = sa; mypre[tid] = sp; cursor[tid] = 0; }
    __syncthreads();
    if (tid == 0) { int run = 0;
        for (int e = 0; e < NEXP; ++e) { base[e] = run * 256; const int n = (total[e] + 255) >> 8; ntl[e] = n; run += n; }
        base[NEXP] = run * 256; ntl[NEXP] = S_ / 256; total[NEXP] = S_; run += S_ / 256;
        if (b == 0) { F.ctl[CW_NT] = (unsigned)run; } }
    __syncthreads();
    if (b == 0) { int* te = WSP(int, WS_TILEE);
        for (int e = tid; e < NE1; e += 512) { const int t0 = base[e] >> 8; for (int i = 0; i < ntl[e]; ++i) te[t0 + i] = e; } }
    { const int tl = tid >> 3, k = tid & 7, t = b * 64 + tl; const int e = WSP(int, WS_EIDX)[(size_t)t * 8 + k]; const float w = WSP(float, WS_EW)[(size_t)t * 8 + k];
      const int r = atomicAdd((int*)&cursor[e], 1); const int slot = base[e] + mypre[e] + r;
      WSP(int, WS_STOK)[slot] = t; WSP(int, WS_SDST)[slot] = t * 8 + k; WSP(float, WS_SW)[slot] = w; }
    if (tid < 64) { const int t = b * 64 + tid, slot = base[NEXP] + t; WSP(int, WS_STOK)[slot] = t; WSP(int, WS_SDST)[slot] = -1; WSP(float, WS_SW)[slot] = 1.f; }
    if (b < NEXP) { const int e = b; for (int s = base[e] + total[e] + tid; s < base[e] + ntl[e] * 256; s += 512) { WSP(int, WS_STOK)[s] = S_; WSP(int, WS_SDST)[s] = -1; WSP(float, WS_SW)[s] = 0.f; } }
    __syncthreads();
}
__device__ __forceinline__ u32x4 ldu16(const void* ubase, unsigned lboff) { return *(const u32x4*)((const char*)ubase + lboff); }
__device__ __forceinline__ f32x4 ldf16(const void* ubase, unsigned lboff) { return *(const f32x4*)((const char*)ubase + lboff); }
__device__ __forceinline__ void p14_final(Frame& F) {
    const int gw = F.bid * NWAVES + F.wave, NGW = F.G * NWAVES, lane = F.lane;
    const float* gf = WSP(float, WS_MODV) + 5 * 2048;
    const unsigned lb2 = (unsigned)lane * 16u, lb4 = (unsigned)lane * 32u;
    for (int t0 = gw; t0 < S_; t0 += NGW) {
        const int t = __builtin_amdgcn_readfirstlane(t0);
        float acc[32];
#pragma unroll
        for (int i = 0; i < 32; ++i) acc[i] = 0.f;
        const bf16_t* yb = WSP(bf16_t, WS_YS) + (size_t)t * 8 * DM;
#pragma unroll 1
        for (int k = 0; k < 8; ++k) { const bf16_t* yr = yb + (size_t)k * DM;
#pragma unroll
            for (int j = 0; j < 4; ++j) { const u32x4 w = ldu16(yr + 512 * j, lb2);
#pragma unroll
                for (int i = 0; i < 4; ++i) { acc[j * 8 + 2 * i] += bf_lo(w[i]); acc[j * 8 + 2 * i + 1] += bf_hi(w[i]); } } }
        float* xr = F.out + (size_t)t * DM; float ss = 0.f;
#pragma unroll
        for (int j = 0; j < 4; ++j) { const f32x4 a = ldf16(xr + 512 * j, lb4), b = ldf16(xr + 512 * j + 4, lb4);
            const f32x4 g0 = ldf16(gf + 512 * j, lb4), g1 = ldf16(gf + 512 * j + 4, lb4);
#pragma unroll
            for (int i = 0; i < 4; ++i) { acc[j * 8 + i] = a[i] + g0[i] * acc[j * 8 + i]; acc[j * 8 + 4 + i] = b[i] + g1[i] * acc[j * 8 + 4 + i]; } }
#pragma unroll
        for (int i = 0; i < 32; ++i) ss += acc[i] * acc[i];
        const float rstd = 1.f / sqrtf(wave_sum(ss) * (1.f / DM) + EPS_);
#pragma unroll
        for (int j = 0; j < 4; ++j) { const f32x4 g0 = ldf16(F.final_norm_g + 512 * j, lb4), g1 = ldf16(F.final_norm_g + 512 * j + 4, lb4);
            f32x4 o0, o1;
#pragma unroll
            for (int i = 0; i < 4; ++i) { o0[i] = acc[j * 8 + i] * rstd * g0[i]; o1[i] = acc[j * 8 + 4 + i] * rstd * g1[i]; }
            *(f32x4*)((char*)(xr + 512 * j) + lb4) = o0; *(f32x4*)((char*)(xr + 512 * j + 4) + lb4) = o1; }
    }
}
template <int MODE> __device__ __forceinline__ att::BlockRef make_ref(Frame& F, int L, int pass) {
    att::BlockRef R;
    if constexpr (MODE == 0) {
        const int p = L >> 9, rem = L & 511, h = rem & 7, idx = rem >> 3, d = (p == 0) ? 1 : (p == 1 ? 4 : 16), nbp = 64 / d, r = idx / nbp, b = idx % nbp;
        const bf16_t* pj = WSP(bf16_t, WS_PROJ) + (size_t)r * D_INP + h * 128;
        R.Q = pj; R.K = pj + 1024; R.V = pj + 2048; R.qs = R.ks = R.vs = d * D_INP;
        R.O = WSP(bf16_t, WS_OSWA) + ((size_t)p * S_ + r) * 1024 + h * 128; R.os = d * 1024;
        R.QR = nullptr; R.KR = nullptr;
        R.POS = WSP(float, WS_POSF) + r; R.ps = d; R.LSE = WSP(float, WS_LSE) + ((size_t)p * S_ + r) * 8 + h; R.ls = d * 8;
        R.P0 = 256 * b; R.skv = S_ / d; R.W = 129; R.slopeS = __builtin_amdgcn_exp2f(-(float)(h + 1)) * (1.f / att::Cfg<0>::SCALE);
    } else {
        const int h = L & 7, xx = L >> 3, qb = pass == 0 ? xx : 63 - xx;
        R.Q = WSP(bf16_t, WS_QM) + h * 128; R.QR = WSP(bf16_t, WS_QM) + 1024 + h * 64; R.qs = 1536;
        R.K = WSP(bf16_t, WS_KV) + h * 256; R.V = R.K + 128; R.ks = R.vs = 2048; R.KR = WSP(bf16_t, WS_KR);
        R.O = WSP(bf16_t, WS_OMLA) + h * 128; R.os = 1024;
        R.POS = nullptr; R.LSE = nullptr; R.ps = 0; R.ls = 0;
        R.P0 = 256 * qb; R.skv = S_; R.W = 1 << 30; R.slopeS = 0.f;
    }
    return R;
}
template <int MODE> __device__ __forceinline__ void attn_stream(Frame& F) {
    constexpr int PER = MODE == 0 ? 1 : 2, TOTAL = MODE == 0 ? 1536 : 256;
    int L = F.bid; if (L >= TOTAL) return;
    int pass = 0;
    att::BlockRef cur = make_ref<MODE>(F, L, pass);
    att::Seam<MODE> S;
    att::attn_prime<MODE>(cur, F.ldsg, S);
    for (;;) {
        int Ln = L, passn = pass + 1; bool last = false;
        if (passn == PER) { passn = 0; Ln = L + F.G; if (Ln >= TOTAL) { last = true; Ln = L; passn = pass; } }
        const att::BlockRef nxt = last ? cur : make_ref<MODE>(F, Ln, passn);
        att::attn_block<MODE>(cur, nxt, F.ldsg, S);
        if (last) break;
        cur = nxt; L = Ln; pass = passn;
    }
}

constexpr int N_PHASES = 16;
struct Args { const void* in[24]; float* out; unsigned char* ws; int ph_lo, ph_hi, li, pad; };
__global__ void __launch_bounds__(NWAVES * 64, 2) mk_fwd(Args args) {
    extern __shared__ __attribute__((aligned(16))) unsigned char lds[];
    Frame F;
    F.lds = (LAS unsigned char*)lds; F.ldsg = (char*)lds;
    F.MISC = (volatile LAS unsigned*)(F.lds + MISC_OFF);
    F.tid = threadIdx.x; F.lane = F.tid & 63; F.wave = __builtin_amdgcn_readfirstlane(F.tid >> 6);
    F.G = gridDim.x; F.bid = blockIdx.x;
    F.ws = args.ws; F.ctl = (unsigned*)(args.ws + WS_CTL);
    F.x = (const float*)args.in[0]; F.c = (const float*)args.in[1]; F.positions = (const int*)args.in[2]; F.norm_attn_g = (const float*)args.in[3];
    F.w_ada = (const float*)args.in[4]; F.b_ada = (const float*)args.in[5]; F.w_in = (const float*)args.in[6]; F.g_q = (const float*)args.in[7];
    F.w_uq = (const float*)args.in[8]; F.g_kv = (const float*)args.in[9]; F.w_ukv = (const float*)args.in[10]; F.g_out_swa = (const float*)args.in[11];
    F.g_out_mla = (const float*)args.in[12]; F.w_o = (const float*)args.in[13]; F.norm_ffn_g = (const float*)args.in[14]; F.w_router = (const float*)args.in[15];
    F.router_bias = (const float*)args.in[16]; F.w_exp_gate = (const float*)args.in[17]; F.w_exp_up = (const float*)args.in[18]; F.w_exp_down = (const float*)args.in[19];
    F.w_sh_gate = (const float*)args.in[20]; F.w_sh_up = (const float*)args.in[21]; F.w_sh_down = (const float*)args.in[22]; F.final_norm_g = (const float*)args.in[23];
    F.out = args.out;
    for (int u = F.tid; u < 256; u += NWAVES * 64) ((LAS unsigned*)(F.lds + LDSCTL_OFF))[u] = 0u;
    __syncthreads();
    XcdBarrier bar; bar.bar = F.ctl + CW_BAR; bar.x = 0; bar.st = nullptr;
    if (MK_N_LAUNCHES == 1) bar = xcd_barrier_post(F.ctl + CW_BAR, F.MISC + 8);
    const int lo = args.ph_lo, hi = args.ph_hi;
#ifndef PH_MASK
#define PH_MASK 0xFFFF
#endif
#define IN(k) (((PH_MASK >> (k)) & 1) && lo <= (k) && (k) < hi)
#define SEAM(k) do { if (IN(k) && IN((k) + 1)) xcd_barrier(bar); } while (0)
    const int gw = F.bid * NWAVES + F.wave, NGW = F.G * NWAVES;
    float* modv = WSP(float, WS_MODV);

    if (IN(0)) { p0_prologue(F); } SEAM(0);
    if (IN(1)) { p1_mod(F); } SEAM(1);
    if (IN(2)) { for (int t = gw; t < S_; t += NGW) norm_mod_row(F.x + (size_t)t * DM, modv, modv + 2048, WSP(bf16_t, WS_H) + (size_t)t * DM, F.lane); } SEAM(2);
    if (IN(3)) {
        pg8::Gemm g{WSP(bf16_t, WS_H), WSP(bf16_t, WS_WIN), DM, DM}; pg8::StaticOrder S; S.init(S_, D_INP, F.G, F.bid);
        pg8::EpiBf16R E{WSP(bf16_t, WS_PROJ), D_INP, nullptr};
        pg8::gemm_phase(F.lds, g, S, E, pg8::RowIdent{});
    } SEAM(3);
    if (IN(4)) { p3_prep(F); } SEAM(4);
    if (IN(5)) {
        { pg8::Gemm g{WSP(bf16_t, WS_PROJ) + 3072, WSP(bf16_t, WS_WUQ), D_INP, 512}; pg8::StaticOrder S; S.init(S_, 1536, F.G, F.bid);
          pg8::EpiQ E{WSP(bf16_t, WS_QM), WSP(float, WS_RQ), WSP(float, WS_COS), WSP(float, WS_SIN)};
          pg8::gemm_phase(F.lds, g, S, E, pg8::RowIdent{}); }
        { pg8::Gemm g{WSP(bf16_t, WS_PROJ) + 3584, WSP(bf16_t, WS_WUKV), D_INP, 256}; pg8::StaticOrder S; S.init(S_, 2048, F.G, F.bid);
          pg8::EpiBf16R E{WSP(bf16_t, WS_KV), 2048, WSP(float, WS_RKV)};
          pg8::gemm_phase(F.lds, g, S, E, pg8::RowIdent{}); }
    } SEAM(5);
    #ifndef ATT_SEL
#define ATT_SEL 3
#endif
    if (IN(6)) { if (ATT_SEL & 1) attn_stream<0>(F); __syncthreads(); if (ATT_SEL & 2) attn_stream<1>(F); } SEAM(6);
    if (IN(7)) { p6_mix(F); } SEAM(7);
    if (IN(8)) {
        pg8::Gemm g{WSP(bf16_t, WS_MIX), WSP(bf16_t, WS_WO), DM, DM}; pg8::StaticOrder S; S.init(S_, DM, F.G, F.bid);
        pg8::EpiWo E{F.x, modv + 2 * 2048, F.out};
        pg8::gemm_phase(F.lds, g, S, E, pg8::RowIdent{});
    } SEAM(8);
    if (IN(9)) { for (int t = gw; t < S_; t += NGW) norm_mod_row(F.out + (size_t)t * DM, modv + 3 * 2048, modv + 4 * 2048, WSP(bf16_t, WS_H) + (size_t)t * DM, F.lane); } SEAM(9);
    if (IN(10)) {
        pg8::Gemm g{WSP(bf16_t, WS_H), WSP(bf16_t, WS_WR), DM, DM}; pg8::StaticOrder S; S.init(S_, 256, F.G, F.bid);
        pg8::EpiLogits E{WSP(float, WS_LOGIT)};
        pg8::gemm_phase(F.lds, g, S, E, pg8::RowIdent{});
    } SEAM(10);
    if (IN(11)) { p10_route(F); } SEAM(11);
    if (IN(12)) { p11_slots(F); } SEAM(12);
    if (IN(13) || IN(14)) {
        LAS int* tile_e = (LAS int*)(F.lds + TILE_OFF);
        const int NT = (int)__hip_atomic_load(F.ctl + CW_NT, __ATOMIC_RELAXED, __HIP_MEMORY_SCOPE_AGENT);
        const int ntc = NT < MAX_TILES ? NT : MAX_TILES;
        for (int i = F.tid; i < ntc; i += NWAVES * 64) tile_e[i] = WSP(int, WS_TILEE)[i];
        __syncthreads();
        if (IN(13)) {
            pg8::Gemm g{WSP(bf16_t, WS_H), WSP(bf16_t, WS_WG1), DM, DM}; pg8::GroupedOrder S{tile_e, 4, ntc * 4, F.G, F.bid};
            pg8::EpiAct E{WSP(bf16_t, WS_ACT)};
            pg8::gemm_phase(F.lds, g, S, E, pg8::RowGather{WSP(int, WS_STOK)});
        }
        SEAM(13);
        if (IN(14)) {
            pg8::Gemm g{WSP(bf16_t, WS_ACT), WSP(bf16_t, WS_WG2), 512, 512}; pg8::GroupedOrder S{tile_e, 8, ntc * 8, F.G, F.bid};
            pg8::EpiDown E{WSP(bf16_t, WS_YS), F.out, modv + 5 * 2048, WSP(int, WS_SDST), WSP(float, WS_SW), WSP(int, WS_STOK)};
            pg8::gemm_phase(F.lds, g, S, E, pg8::RowIdent{});
        }
    }
    SEAM(14);
    if (IN(15)) { p14_final(F); }
#undef IN
#undef SEAM
}

extern "C" void kernel_launch(void* const* d_in, const int* in_sizes, int n_in, void* d_out, int out_size, void* d_ws, size_t ws_size, hipStream_t stream) {
    static int grid = 0;
    if (grid == 0) {
        if (n_in != 24 || in_sizes[0] != S_ * DM || out_size != S_ * DM || ws_size < WS_END) {
            fprintf(stderr, "kernel_launch: unexpected shapes (n_in %d, in0 %d, out %d, ws %zu < %zu?); nothing launched\n", n_in, n_in > 0 ? in_sizes[0] : -1, out_size, ws_size, (size_t)WS_END); grid = -1; return; }
        int dev = 0, cus = 0, per_cu = 0;
        if (hipGetDevice(&dev) != hipSuccess || hipDeviceGetAttribute(&cus, hipDeviceAttributeMultiprocessorCount, dev) != hipSuccess) { fprintf(stderr, "kernel_launch: device query failed\n"); grid = -1; return; }
        if (hipFuncSetAttribute((const void*)mk_fwd, hipFuncAttributeMaxDynamicSharedMemorySize, LDS_BYTES) != hipSuccess) { fprintf(stderr, "kernel_launch: hipFuncSetAttribute failed\n"); grid = -1; return; }
        if (hipOccupancyMaxActiveBlocksPerMultiprocessor(&per_cu, (const void*)mk_fwd, NWAVES * 64, LDS_BYTES) != hipSuccess || per_cu < 1)
            fprintf(stderr, "kernel_launch: note: occupancy query reports %d workgroups per CU\n", per_cu);
        (void)hipGetLastError();
        if (cus < 256) { fprintf(stderr, "kernel_launch: needs 256 CUs (one resident workgroup each), device has %d; nothing launched\n", cus); grid = -1; return; }
        grid = 256;
    }
    if (grid < 0) return;
    if (hipMemsetAsync((char*)d_ws + WS_CTL, 0, CTL_ZERO_BYTES, stream) != hipSuccess) { fprintf(stderr, "kernel_launch: memset failed\n"); return; }
    Args a{};
    for (int i = 0; i < 24; ++i) a.in[i] = d_in[i];
    a.out = (float*)d_out; a.ws = (unsigned char*)d_ws;
#if MK_N_LAUNCHES == 1
    a.ph_lo = 0; a.ph_hi = N_PHASES; a.li = 0;
    hipLaunchKernelGGL(mk_fwd, dim3(grid), dim3(NWAVES * 64), LDS_BYTES, stream, a);
#else
    for (int li = 0; li < N_PHASES; ++li) { a.ph_lo = li; a.ph_hi = li + 1; a.li = li;
        hipLaunchKernelGGL(mk_fwd, dim3(grid), dim3(NWAVES * 64), LDS_BYTES, stream, a); }
#endif
    const hipError_t le = hipPeekAtLastError();
    if (le != hipSuccess) fprintf(stderr, "kernel_launch: launch failed: %s\n", hipGetErrorName(le));
}
```

```cpp
#define ATT_PIPE 2
#include <hip/hip_runtime.h>
#include <cstdio>
#include <cstdint>

#ifndef MK_N_LAUNCHES
#define MK_N_LAUNCHES 1
#endif

#define LAS __attribute__((address_space(3)))
#define GAS __attribute__((address_space(1)))
typedef unsigned short bf16_t;
typedef short bf16x8 __attribute__((ext_vector_type(8)));
typedef short s16x4 __attribute__((ext_vector_type(4)));
typedef float f32x4 __attribute__((ext_vector_type(4)));
typedef float f32x16 __attribute__((ext_vector_type(16)));
typedef unsigned u32x4 __attribute__((ext_vector_type(4)));
typedef unsigned u32x2 __attribute__((ext_vector_type(2)));

constexpr int S_ = 16384, DM = 2048, D_INP = 4096;
constexpr int NEXP = 64, NE1 = 65;
constexpr int MAX_TILES = 642, MAX_SLOTS = MAX_TILES * 256;
constexpr float EPS_ = 1e-6f;

__device__ __forceinline__ unsigned cvt_pk_bf16(float lo, float hi) { unsigned r; asm volatile("v_cvt_pk_bf16_f32 %0, %1, %2" : "=v"(r) : "v"(lo), "v"(hi)); return r; }
__device__ __forceinline__ unsigned f2bf(float f) { unsigned u = __builtin_bit_cast(unsigned, f); return (u + 0x7fffu + ((u >> 16) & 1u)) >> 16; }
__device__ __forceinline__ unsigned pk2(float lo, float hi) { return f2bf(lo) | (f2bf(hi) << 16); }
__device__ __forceinline__ float bf_lo(unsigned w) { return __builtin_bit_cast(float, w << 16); }
__device__ __forceinline__ float bf_hi(unsigned w) { return __builtin_bit_cast(float, w & 0xffff0000u); }
__device__ __forceinline__ int ltid() { int t = threadIdx.x; asm volatile("" : "+v"(t)); return t; }
__device__ __forceinline__ float wave_sum(float v) {
#pragma unroll
    for (int o = 1; o < 64; o <<= 1) v += __shfl_xor(v, o);
    return v;
}

namespace pg8 {
constexpr int BM = 256, BK = 64, HALF = 128, HTB = HALF * BK * 2, STAGE_BYTES = 8 * HTB, NXCD = 8, WGM = 8;
__host__ __device__ __forceinline__ int lds_byte(int r, int c) { const int st = (r >> 4) * 2 + (c >> 5), rr = r & 15, cc = c & 31, ob = rr * 64 + cc * 2; return st * 1024 + (ob ^ (((ob >> 9) & 1) << 5)); }
__host__ __device__ __forceinline__ void stage_rc(int b, int& R, int& C) { const int st = b / 1024, sb = b % 1024, swz = sb ^ (((sb >> 9) & 1) << 5); R = (st >> 1) * 16 + swz / 64; C = (st & 1) * 32 + (swz % 64) / 2; }
__host__ __device__ __forceinline__ int perm32(int rho) { const int n = rho >> 4, i = rho & 15; return 8 * (i >> 2) + 4 * n + (i & 3); }

struct Unit { int pm, pn, pb, e; };
struct Gemm { const bf16_t* A; const bf16_t* Bt; int lda, K; };

struct StaticOrder {
    int nM, nN, nwg, G, c;
    __host__ __device__ void init(int M, int N, int G_, int c_) { nM = M / BM; nN = N / BM; nwg = nM * nN; G = G_; c = c_; }
    __host__ __device__ bool next(int i, Unit& u) const {
        const long L = (long)i * G + c; if (L >= nwg) return false;
        int wgid = (int)L; { const int q = nwg / NXCD, r = nwg % NXCD, xcd = wgid % NXCD, off = wgid / NXCD; wgid = (xcd < r ? xcd * (q + 1) : r * (q + 1) + (xcd - r) * q) + off; }
        const int nig = WGM * nN, gid = wgid / nig, fm = gid * WGM, gsz = (nM - fm) < WGM ? (nM - fm) : WGM;
        u.pm = fm + ((wgid % nig) % gsz); u.pn = (wgid % nig) / gsz; u.pb = u.pn; u.e = 0; return true;
    }
};
struct GroupedOrder {
    const LAS int* list; int npn, nunits, stride, c;
    __device__ bool next(int i, Unit& u) const {
        const int L = i * stride + c; if (L >= nunits) return false;
        const int v = list[L / npn], pn = L % npn, e = v & 255;
        u.pm = v >> 8; u.pn = pn; u.pb = e * npn + pn; u.e = e; return true;
    }
};
struct GroupedFlat {
    const LAS int* list; int npn, ntiles, g, c;
    __device__ bool next(int i, Unit& u) const {
        const int tpr = 256 / npn, ngrp = npn / g, xper = 8 / ngrp;
        const int xcd = c & 7, j = c >> 3, pgrp = xcd % ngrp, tsub = xcd / ngrp;
        const int lt = j / g, lp = j % g;
        const int tile = i * tpr + lt * xper + tsub, pn = pgrp * g + lp;
        if (tile >= ntiles) return false;
        const int v = list[tile], e = v & 255;
        u.pm = v >> 8; u.pn = pn; u.pb = e * npn + pn; u.e = e; return true;
    }
};
struct RowIdent { __device__ __forceinline__ int operator()(int r) const { return r; } };
struct RowGather { const int* tok; __device__ __forceinline__ int operator()(int r) const { return tok[r]; } };

template <class Epi, class Sched, class RowMap>
__device__ __forceinline__ void gemm_phase(LAS unsigned char* lds, const Gemm g, const Sched& S, const Epi& E, const RowMap& RM) {
    const int tid = ltid(), wid = __builtin_amdgcn_readfirstlane(tid >> 6), lane = tid & 63, wr = wid >> 2, wc = wid & 3, fr = lane & 15, fq = lane >> 4;
    const int K = g.K, nt = K / BK;
    unsigned voffB[2]; int Rr[2], Cc[2];
#pragma unroll
    for (int i = 0; i < 2; ++i) { int R, C; stage_rc(tid * 16 + i * 8192, R, C); const int Rb = Epi::PERM ? ((R & ~31) + perm32(R & 31)) : R;
        Rr[i] = R; Cc[i] = C; voffB[i] = (unsigned)(Rb * K + C) * 2u; }
    const size_t kstep = (size_t)(BK * 2);
    const size_t hstep = (size_t)HALF * K * 2;
    const size_t tstep = 2 * hstep;
    const unsigned ldsw = (unsigned)wid * 1024u;
    const int aoff = lds_byte(wr * 64 + fr, fq * 8), boff = lds_byte(wc * 32 + fr, fq * 8);
#define PG8_SA(b, h) (((b) * 2 + (h)) * HTB)
#define PG8_SB(b, h) ((4 + (b) * 2 + (h)) * HTB)
#define PG8_STAGE(bufoff, gbase, voff) do { _Pragma("unroll") for (int _i = 0; _i < 2; ++_i) \
        __builtin_amdgcn_global_load_lds((const unsigned*)((const char*)(gbase) + (voff)[_i]), (LAS unsigned*)(lds + (bufoff) + ldsw + _i * 8192), 16, 0, 0); } while (0)
#define PG8_LDA(dst, b, h) do { _Pragma("unroll") for (int m = 0; m < 4; ++m) _Pragma("unroll") for (int k = 0; k < 2; ++k) dst[m][k] = *(const LAS bf16x8*)(lds + PG8_SA(b, h) + aoff + m * 2048 + k * 1024); } while (0)
#define PG8_LDB(dst, b, h) do { _Pragma("unroll") for (int n = 0; n < 2; ++n) _Pragma("unroll") for (int k = 0; k < 2; ++k) dst[n][k] = *(const LAS bf16x8*)(lds + PG8_SB(b, h) + boff + n * 2048 + k * 1024); } while (0)
#define PG8_MMA(ai, bj, At, Bt) do { __builtin_amdgcn_s_setprio(1); _Pragma("unroll") for (int m = 0; m < 4; ++m) _Pragma("unroll") for (int n = 0; n < 2; ++n) _Pragma("unroll") for (int k = 0; k < 2; ++k) \
        acc[ai][bj][m][n] = __builtin_amdgcn_mfma_f32_16x16x32_bf16(Bt[n][k], At[m][k], acc[ai][bj][m][n], 0, 0, 0); __builtin_amdgcn_s_setprio(0); } while (0)
#define PG8_WAIT_V(n) asm volatile("s_waitcnt vmcnt(" #n ")" ::: "memory")
#define PG8_WAIT_L(n) asm volatile("s_waitcnt lgkmcnt(" #n ")" ::: "memory")
#define PG8_BAR __builtin_amdgcn_s_barrier()
#define PG8_SCHED __builtin_amdgcn_sched_barrier(0)
#define PG8_VOFF(u, v) do { _Pragma("unroll") for (int _h = 0; _h < 2; ++_h) _Pragma("unroll") for (int _i = 0; _i < 2; ++_i) \
        v[_h][_i] = (unsigned)(((size_t)RM((u).pm * BM + _h * HALF + Rr[_i]) * (size_t)g.lda + (size_t)Cc[_i]) * 2u); } while (0)
    Unit cur, nxt; int ui = 0;
    if (!S.next(0, cur)) return;
    f32x4 acc[2][2][4][2];
#pragma unroll
    for (int a = 0; a < 2; ++a)
#pragma unroll
        for (int b = 0; b < 2; ++b)
#pragma unroll
            for (int m = 0; m < 4; ++m)
#pragma unroll
                for (int n = 0; n < 2; ++n) acc[a][b][m][n] = (f32x4){0.f, 0.f, 0.f, 0.f};
    bf16x8 At[4][2], B0[2][2], B1[2][2];
    unsigned vc[2][2], vn[2][2];
    PG8_VOFF(cur, vc);
    const char* pA = (const char*)g.A;
    const char* cB = (const char*)g.Bt + (size_t)cur.pb * tstep;
    PG8_STAGE(PG8_SB(0, 0), cB, voffB); PG8_STAGE(PG8_SB(0, 1), cB + hstep, voffB); PG8_STAGE(PG8_SA(0, 0), pA, vc[0]); PG8_STAGE(PG8_SA(0, 1), pA, vc[1]);
    if (wr == 1) PG8_BAR;
    PG8_WAIT_V(2); PG8_BAR;
    PG8_STAGE(PG8_SB(1, 0), cB + kstep, voffB); PG8_STAGE(PG8_SA(1, 0), pA + kstep, vc[0]); PG8_STAGE(PG8_SB(1, 1), cB + hstep + kstep, voffB);
    PG8_WAIT_V(6); PG8_BAR;
    for (;;) {
        const bool has_next = S.next(ui + 1, nxt);
        if (has_next) { PG8_VOFF(nxt, vn); } else { vn[0][0] = vc[0][0]; vn[0][1] = vc[0][1]; vn[1][0] = vc[1][0]; vn[1][1] = vc[1][1]; }
        const char* nB = has_next ? (const char*)g.Bt + (size_t)nxt.pb * tstep : cB;
        for (int t = 0; t < nt; t += 2) {
            const bool last = (t == nt - 2);
            const char* a1 = pA + (size_t)(t + 1) * kstep;
            const char* a2 = last ? pA : pA + (size_t)(t + 2) * kstep; const char* b2 = last ? nB : cB + (size_t)(t + 2) * kstep;
            const char* a3 = a2 + kstep; const char* b3 = b2 + kstep;
            unsigned v2[2][2];
            v2[0][0] = last ? vn[0][0] : vc[0][0]; v2[0][1] = last ? vn[0][1] : vc[0][1]; v2[1][0] = last ? vn[1][0] : vc[1][0]; v2[1][1] = last ? vn[1][1] : vc[1][1];
            PG8_LDB(B0, 0, 0); PG8_LDB(B1, 0, 1); PG8_SCHED; PG8_LDA(At, 0, 0); PG8_STAGE(PG8_SA(1, 1), a1, vc[1]);
            PG8_WAIT_V(8); PG8_WAIT_L(0); PG8_BAR; PG8_MMA(0, 0, At, B0); PG8_MMA(0, 1, At, B1); PG8_BAR; PG8_SCHED;
            PG8_LDA(At, 0, 1); PG8_STAGE(PG8_SB(0, 0), b2, voffB); PG8_STAGE(PG8_SB(0, 1), b2 + hstep, voffB); PG8_STAGE(PG8_SA(0, 0), a2, v2[0]);
            PG8_WAIT_V(8); PG8_WAIT_L(0); PG8_BAR; PG8_MMA(1, 0, At, B0); PG8_MMA(1, 1, At, B1); PG8_BAR; PG8_SCHED;
            PG8_LDB(B0, 1, 0); PG8_LDB(B1, 1, 1); PG8_SCHED; PG8_LDA(At, 1, 0); PG8_STAGE(PG8_SA(0, 1), a2, v2[1]);
            PG8_WAIT_V(8); PG8_WAIT_L(0); PG8_BAR; PG8_MMA(0, 0, At, B0); PG8_MMA(0, 1, At, B1); PG8_BAR; PG8_SCHED;
            PG8_LDA(At, 1, 1); PG8_STAGE(PG8_SB(1, 0), b3, voffB); PG8_STAGE(PG8_SB(1, 1), b3 + hstep, voffB); PG8_STAGE(PG8_SA(1, 0), a3, v2[0]);
            PG8_WAIT_V(8); PG8_WAIT_L(0); PG8_BAR; PG8_MMA(1, 0, At, B0); PG8_MMA(1, 1, At, B1); PG8_BAR; PG8_SCHED;
        }
        if (wr == 0) PG8_BAR;
        E(acc, cur, wr, wc, fr, fq);
        if (!has_next) break;
#pragma unroll
        for (int a = 0; a < 2; ++a)
#pragma unroll
            for (int b = 0; b < 2; ++b)
#pragma unroll
                for (int m = 0; m < 4; ++m)
#pragma unroll
                    for (int n = 0; n < 2; ++n) acc[a][b][m][n] = (f32x4){0.f, 0.f, 0.f, 0.f};
        cur = nxt; cB = nB; ++ui;
        vc[0][0] = vn[0][0]; vc[0][1] = vn[0][1]; vc[1][0] = vn[1][0]; vc[1][1] = vn[1][1];
        if (wr == 1) PG8_BAR;
    }
    PG8_WAIT_V(0);
    PG8_BAR;
#undef PG8_SA
#undef PG8_SB
#undef PG8_STAGE
#undef PG8_LDA
#undef PG8_LDB
#undef PG8_MMA
#undef PG8_WAIT_V
#undef PG8_WAIT_L
#undef PG8_BAR
#undef PG8_SCHED
#undef PG8_VOFF
}
}
namespace pg8 {
__device__ __forceinline__ void st16_sc1(void* p, u32x4 v) { asm volatile("global_store_dwordx4 %0, %1, off sc1" :: "v"(p), "v"(v) : "memory"); }
#ifndef YS_SC1
#define YS_SC1 0
#endif
__device__ __forceinline__ u32x4 pack8s(f32x4 v0, f32x4 v1, float sc) {
    u32x4 w; w.x = cvt_pk_bf16(v0[0] * sc, v0[1] * sc); w.y = cvt_pk_bf16(v0[2] * sc, v0[3] * sc); w.z = cvt_pk_bf16(v1[0] * sc, v1[1] * sc); w.w = cvt_pk_bf16(v1[2] * sc, v1[3] * sc); return w;
}
struct EpiBf16R {
    static constexpr bool PERM = true;
    bf16_t* O; int ldc; const float* rs;
    __device__ __forceinline__ void operator()(const f32x4 (&acc)[2][2][4][2], const Unit& u, int wr, int wc, int fr, int fq) const {
        const int row0 = u.pm * BM + wr * 64 + fr, col0 = u.pn * BM + wc * 32 + 8 * fq;
        float rsv[2][4];
#pragma unroll
        for (int ai = 0; ai < 2; ++ai)
#pragma unroll
            for (int m = 0; m < 4; ++m) rsv[ai][m] = rs ? rs[row0 + ai * HALF + m * 16] : 1.f;
#pragma unroll
        for (int ai = 0; ai < 2; ++ai)
#pragma unroll
            for (int m = 0; m < 4; ++m) { const int row = row0 + ai * HALF + m * 16; const float sc = rsv[ai][m]; bf16_t* rowp = O + (size_t)row * ldc + col0;
#pragma unroll
                for (int bj = 0; bj < 2; ++bj) *(u32x4*)(rowp + bj * HALF) = pack8s(acc[ai][bj][m][0], acc[ai][bj][m][1], sc); }
    }
};
struct EpiQ {
    static constexpr bool PERM = true;
    bf16_t* QM; const float* rq; const float* COS; const float* SIN;
    __device__ __forceinline__ void operator()(const f32x4 (&acc)[2][2][4][2], const Unit& u, int wr, int wc, int fr, int fq) const {
        const int row0 = u.pm * BM + wr * 64 + fr;
        if (u.pn < 4) {
            const int col0 = u.pn * BM + wc * 32 + 8 * fq;
#pragma unroll
            for (int ai = 0; ai < 2; ++ai)
#pragma unroll
                for (int m = 0; m < 4; ++m) { const int row = row0 + ai * HALF + m * 16; const float sc = rq[row]; bf16_t* rowp = QM + (size_t)row * 1536 + col0;
#pragma unroll
                    for (int bj = 0; bj < 2; ++bj) *(u32x4*)(rowp + bj * HALF) = pack8s(acc[ai][bj][m][0], acc[ai][bj][m][1], sc); }
        } else {
            const int head = 4 * (u.pn - 4) + wc, j0 = 8 * fq;
#pragma unroll
            for (int ai = 0; ai < 2; ++ai)
#pragma unroll
                for (int m = 0; m < 4; ++m) { const int row = row0 + ai * HALF + m * 16; const float sc = rq[row];
                    const f32x4 c0 = *(const f32x4*)(COS + (size_t)row * 32 + j0), c1 = *(const f32x4*)(COS + (size_t)row * 32 + j0 + 4);
                    const f32x4 s0 = *(const f32x4*)(SIN + (size_t)row * 32 + j0), s1 = *(const f32x4*)(SIN + (size_t)row * 32 + j0 + 4);
                    const f32x4 x1a = acc[ai][0][m][0], x1b = acc[ai][0][m][1], x2a = acc[ai][1][m][0], x2b = acc[ai][1][m][1];
                    const f32x4 o1a = x1a * c0 - x2a * s0, o1b = x1b * c1 - x2b * s1, o2a = x2a * c0 + x1a * s0, o2b = x2b * c1 + x1b * s1;
                    bf16_t* rowp = QM + (size_t)row * 1536 + 1024 + head * 64 + j0;
                    *(u32x4*)(rowp) = pack8s(o1a, o1b, sc); *(u32x4*)(rowp + 32) = pack8s(o2a, o2b, sc); }
        }
    }
};
struct EpiWo {
    static constexpr bool PERM = false;
    const float* x; const float* gate; float* out;
    __device__ __forceinline__ void operator()(const f32x4 (&acc)[2][2][4][2], const Unit& u, int wr, int wc, int fr, int fq) const {
        const int row0 = u.pm * BM + wr * 64 + fr, col0 = u.pn * BM + wc * 32 + 4 * fq;
        f32x4 gv[2][2];
#pragma unroll
        for (int bj = 0; bj < 2; ++bj)
#pragma unroll
            for (int n = 0; n < 2; ++n) gv[bj][n] = *(const f32x4*)(gate + col0 + bj * HALF + n * 16);
#pragma unroll
        for (int ai = 0; ai < 2; ++ai)
#pragma unroll
            for (int m = 0; m < 4; ++m) { const size_t off = (size_t)(row0 + ai * HALF + m * 16) * DM + col0;
#pragma unroll
                for (int bj = 0; bj < 2; ++bj)
#pragma unroll
                    for (int n = 0; n < 2; ++n) { const f32x4 xin = *(const f32x4*)(x + off + bj * HALF + n * 16); *(f32x4*)(out + off + bj * HALF + n * 16) = xin + gv[bj][n] * acc[ai][bj][m][n]; }
                if (m & 1) asm volatile("" ::: "memory"); }
    }
};
struct EpiLogits {
    static constexpr bool PERM = false;
    float* L;
    __device__ __forceinline__ void operator()(const f32x4 (&acc)[2][2][4][2], const Unit& u, int wr, int wc, int fr, int fq) const {
        if (wc >= 2) return;
        const int row0 = u.pm * BM + wr * 64 + fr, col0 = wc * 32 + 4 * fq;
#pragma unroll
        for (int ai = 0; ai < 2; ++ai)
#pragma unroll
            for (int m = 0; m < 4; ++m) { float* rowp = L + (size_t)(row0 + ai * HALF + m * 16) * 64 + col0;
#pragma unroll
                for (int n = 0; n < 2; ++n) *(f32x4*)(rowp + n * 16) = acc[ai][0][m][n]; }
    }
};
__device__ __forceinline__ float silu_mul(float g, float u) { return g * __builtin_amdgcn_rcpf(1.f + __builtin_amdgcn_exp2f(-1.4426950408889634f * g)) * u; }
struct EpiAct {
    static constexpr bool PERM = true;
    bf16_t* ACT;
    __device__ __forceinline__ void operator()(const f32x4 (&acc)[2][2][4][2], const Unit& u, int wr, int wc, int fr, int fq) const {
        const int row0 = u.pm * BM + wr * 64 + fr, col0 = u.pn * HALF + wc * 32 + 8 * fq;
#pragma unroll
        for (int ai = 0; ai < 2; ++ai)
#pragma unroll
            for (int m = 0; m < 4; ++m) { bf16_t* rowp = ACT + (size_t)(row0 + ai * HALF + m * 16) * 512 + col0;
                const f32x4 g0 = acc[ai][0][m][0], g1 = acc[ai][0][m][1], u0 = acc[ai][1][m][0], u1 = acc[ai][1][m][1];
                u32x4 w;
                w.x = cvt_pk_bf16(silu_mul(g0[0], u0[0]), silu_mul(g0[1], u0[1])); w.y = cvt_pk_bf16(silu_mul(g0[2], u0[2]), silu_mul(g0[3], u0[3]));
                w.z = cvt_pk_bf16(silu_mul(g1[0], u1[0]), silu_mul(g1[1], u1[1])); w.w = cvt_pk_bf16(silu_mul(g1[2], u1[2]), silu_mul(g1[3], u1[3]));
                *(u32x4*)rowp = w; }
    }
};
struct EpiDown {
    static constexpr bool PERM = true;
    bf16_t* YS; float* X1; const float* gatef; const int* dst; const float* w; const int* tok; int skip_shared;
    __device__ __forceinline__ void operator()(const f32x4 (&acc)[2][2][4][2], const Unit& u, int wr, int wc, int fr, int fq) const {
        const int row0 = u.pm * BM + wr * 64 + fr, col0 = u.pn * BM + wc * 32 + 8 * fq;
        if (skip_shared == 2) return;
        if (u.e == NEXP) {
            if (skip_shared) return;
            f32x4 gv[2][2]; int tt[2][4];
#pragma unroll
            for (int ai = 0; ai < 2; ++ai)
#pragma unroll
                for (int m = 0; m < 4; ++m) tt[ai][m] = tok[row0 + ai * HALF + m * 16];
#pragma unroll
            for (int bj = 0; bj < 2; ++bj)
#pragma unroll
                for (int n = 0; n < 2; ++n) gv[bj][n] = *(const f32x4*)(gatef + col0 + bj * HALF + n * 4);
#pragma unroll
            for (int ai = 0; ai < 2; ++ai)
#pragma unroll
                for (int m = 0; m < 4; ++m) { float* rowp = X1 + (size_t)tt[ai][m] * DM + col0;
#pragma unroll
                    for (int bj = 0; bj < 2; ++bj)
#pragma unroll
                        for (int n = 0; n < 2; ++n) { f32x4* p = (f32x4*)(rowp + bj * HALF + n * 4); *p = *p + gv[bj][n] * acc[ai][bj][m][n]; }
                    if (m & 1) asm volatile("" ::: "memory"); }
        } else {
            float ss[2][4];
#pragma unroll
            for (int ai = 0; ai < 2; ++ai)
#pragma unroll
                for (int m = 0; m < 4; ++m) ss[ai][m] = w[row0 + ai * HALF + m * 16];
#pragma unroll
            for (int ai = 0; ai < 2; ++ai)
#pragma unroll
                for (int m = 0; m < 4; ++m) { bf16_t* rowp = YS + (size_t)(row0 + ai * HALF + m * 16) * DM + col0;
#pragma unroll
                    for (int bj = 0; bj < 2; ++bj) { const u32x4 pk = pack8s(acc[ai][bj][m][0], acc[ai][bj][m][1], ss[ai][m]);
                        if (YS_SC1) st16_sc1(rowp + bj * HALF, pk); else *(u32x4*)(rowp + bj * HALF) = pk; } }
        }
    }
};
}
namespace att {
constexpr int NW = 8, QBLK = 32, KVBLK = 64, QB = NW * QBLK, D = 128;
constexpr int SHM_V = KVBLK * D * 2, SHM_K = KVBLK * D * 2;
constexpr int OFF_V = 0, OFF_K = 2 * SHM_V, OFF_WS = OFF_K + 2 * SHM_K, OFF_KR = OFF_WS + NW * 64 * 4, SHM_KR = KVBLK * 64 * 2, OFF_POS = OFF_KR + 2 * SHM_KR, OFF_QR = OFF_POS + 2 * 256, LDS_BYTES = OFF_QR + 256 * 64 * 2;
static_assert(LDS_BYTES <= 131072, "attention LDS inside the ring region");

#define KSWZ(row, colB) ((row) * 256 + ((colB) ^ (((row) & 7) << 4)))
#define KRSWZ(row, chunk) ((row) * 128 + ((((chunk) ^ ((row) & 7))) << 4))
#define SBAR() __builtin_amdgcn_sched_barrier(0)
__device__ __forceinline__ int v_st(int k, int c) { const int kk = (k & ~0xC) | ((k & 4) << 1) | ((k & 8) >> 1); return ((kk >> 3) * 4 + (c >> 5)) * 512 + ((kk & 7) * 32 + (c & 31)) * 2; }
__device__ __forceinline__ int v_rd_base(int lane) { return ((lane & 3) << 3) | (((lane >> 2) & 3) << 6) | (((lane >> 4) & 1) << 5) | (((lane >> 5) & 1) << 8); }
constexpr int v_rd_off(int d0, int ks, int half) { return d0 * 512 + ks * 4096 + half * 2048; }
__device__ __forceinline__ int crow(int r, int hi) { return (r & 3) + 8 * (r >> 2) + 4 * hi; }
__device__ __forceinline__ unsigned cvtpk(float lo, float hi) { unsigned r; asm volatile("v_cvt_pk_bf16_f32 %0, %1, %2" : "=v"(r) : "v"(lo), "v"(hi)); return r; }
__device__ __forceinline__ bf16x8 load8(const bf16_t* p) { return *reinterpret_cast<const bf16x8*>(p); }

__device__ __forceinline__ void mask_tile(f32x16& p0, f32x16& p1, int dq, unsigned W) {
    const float NEG = -__builtin_inff();
#pragma unroll
    for (int r = 0; r < 16; ++r) {
        const int c = (r & 3) + 8 * (r >> 2);
        if ((unsigned)(dq - c) >= W) p0[r] = NEG;
        if ((unsigned)(dq - c - 32) >= W) p1[r] = NEG;
    }
}
template <int MODE> struct Cfg;
template <> struct Cfg<0> { static constexpr float SCALE = 0.08838834764831845f; static constexpr bool SK = true, ROPE = false, ALIBI = true; };
template <> struct Cfg<1> { static constexpr float SCALE = 0.07216878364870323f; static constexpr bool SK = false, ROPE = true, ALIBI = false; };
constexpr float THR = 8.f;

template <int MODE>
__device__ __forceinline__ void partialSM(f32x16& p0, f32x16& p1, float& m_reg, float& mn, float& alpha) {
    constexpr float SCALE = Cfg<MODE>::SCALE;
    float pmax = p0[0];
#pragma unroll
    for (int r = 1; r < 16; ++r) pmax = fmaxf(pmax, p0[r]);
#pragma unroll
    for (int r = 0; r < 16; ++r) pmax = fmaxf(pmax, p1[r]);
    { auto rr = __builtin_amdgcn_permlane32_swap(__float_as_uint(pmax), __float_as_uint(pmax), false, false);
      pmax = fmaxf(__uint_as_float(rr[0]), __uint_as_float(rr[1])); }
    constexpr float C2 = 1.4426950408889634f * SCALE;
    if (__builtin_expect(__all((pmax - m_reg) * SCALE <= THR), 1)) { mn = m_reg; alpha = 1.f; }
    else { mn = fmaxf(m_reg, pmax); alpha = __builtin_amdgcn_exp2f((m_reg - mn) * C2); m_reg = mn; }
    const float mnL = -mn * C2;
#pragma unroll
    for (int r = 0; r < 16; ++r) p0[r] = fmaf(p0[r], C2, mnL);
#pragma unroll
    for (int r = 0; r < 16; ++r) p1[r] = fmaf(p1[r], C2, mnL);
#pragma unroll
    for (int r = 0; r < 16; ++r) p0[r] = __builtin_amdgcn_exp2f(p0[r]);
}
__device__ __forceinline__ void finishSM(f32x16& p0, f32x16& p1, float alpha, float& l_reg, bf16x8& pa0, bf16x8& pa1, bf16x8& pa2, bf16x8& pa3) {
#pragma unroll
    for (int r = 0; r < 16; ++r) p1[r] = __builtin_amdgcn_exp2f(p1[r]);
    float ps = 0;
#pragma unroll
    for (int r = 0; r < 16; ++r) ps += p0[r];
#pragma unroll
    for (int r = 0; r < 16; ++r) ps += p1[r];
    { auto rr = __builtin_amdgcn_permlane32_swap(__float_as_uint(ps), __float_as_uint(ps), false, false);
      ps = __uint_as_float(rr[0]) + __uint_as_float(rr[1]); }
    l_reg = l_reg * alpha + ps;
#define PK4(P, B_, OUT) do { unsigned a0 = cvtpk(P[B_+0], P[B_+1]), a1 = cvtpk(P[B_+2], P[B_+3]);                          \
        unsigned b0 = cvtpk(P[B_+4], P[B_+5]), b1 = cvtpk(P[B_+6], P[B_+7]);                                             \
        auto r0 = __builtin_amdgcn_permlane32_swap(a0, b0, false, false); auto r1 = __builtin_amdgcn_permlane32_swap(a1, b1, false, false); \
        u32x4 w = {r0[0], r1[0], r0[1], r1[1]}; OUT = *reinterpret_cast<bf16x8*>(&w); } while (0)
    PK4(p0, 0, pa0); PK4(p0, 8, pa1); PK4(p1, 0, pa2); PK4(p1, 8, pa3);
#undef PK4
}
template <int KB, bool SK, bool ROPE>
__device__ __forceinline__ void qkt(f32x16& p0, f32x16& p1, const char* lds, int r32, int hi, const bf16x8* qr, const char* qrl, bool act) {
    if (SK && !act) { const float NEG = -__builtin_inff();
#pragma unroll
        for (int r = 0; r < 16; ++r) { p0[r] = NEG; p1[r] = NEG; } return; }
    p0 = f32x16{}; p1 = f32x16{};
    const char* kb[4];
#pragma unroll
    for (int dd = 0; dd < 4; ++dd) kb[dd] = lds + OFF_K + KB * SHM_K + KSWZ(r32, (dd * 16 + hi * 8) * 2);
#pragma unroll
    for (int d0 = 0; d0 < 8; ++d0) { const char* a = kb[d0 & 3] + (d0 >> 2) * 128;
        bf16x8 b0 = *reinterpret_cast<const bf16x8*>(a);
        bf16x8 b1 = *reinterpret_cast<const bf16x8*>(a + 32 * 256);
        p0 = __builtin_amdgcn_mfma_f32_32x32x16_bf16(b0, qr[d0], p0, 0, 0, 0);
        p1 = __builtin_amdgcn_mfma_f32_32x32x16_bf16(b1, qr[d0], p1, 0, 0, 0); }
    if constexpr (ROPE) {
#pragma unroll
        for (int d0 = 0; d0 < 4; ++d0) { const char* a = lds + OFF_KR + KB * SHM_KR + KRSWZ(r32, 2 * d0 + hi);
            bf16x8 b0 = *reinterpret_cast<const bf16x8*>(a);
            bf16x8 b1 = *reinterpret_cast<const bf16x8*>(a + 32 * 128);
            const bf16x8 qf = *reinterpret_cast<const bf16x8*>(qrl + d0 * 1024);
            p0 = __builtin_amdgcn_mfma_f32_32x32x16_bf16(b0, qf, p0, 0, 0, 0);
            p1 = __builtin_amdgcn_mfma_f32_32x32x16_bf16(b1, qf, p1, 0, 0, 0); }
    }
}
template <int VB, bool SK>
__device__ __forceinline__ void pv_tile(f32x16* o, int vb0, bf16x8 pa0, bf16x8 pa1, bf16x8 pa2, bf16x8 pa3, bool act) {
    if (SK && !act) return;
#define TRRD(dst, off) asm volatile("ds_read_b64_tr_b16 %0, %1 offset:%2" : "=&v"(dst) : "v"(vb0), "i"(off) : "memory")
#define PV_D0(d0) do { s16x4 l0, l1, l2, l3, h0, h1, h2, h3; constexpr int b_ = OFF_V + VB * SHM_V + v_rd_off(d0, 0, 0); \
        TRRD(l0, b_); TRRD(h0, b_ + 2048); TRRD(l1, b_ + 4096); TRRD(h1, b_ + 6144); TRRD(l2, b_ + 8192); TRRD(h2, b_ + 10240); TRRD(l3, b_ + 12288); TRRD(h3, b_ + 14336); \
        asm volatile("s_waitcnt lgkmcnt(0)" ::: "memory"); SBAR();   \
        o[d0] = __builtin_amdgcn_mfma_f32_32x32x16_bf16(pa0, (bf16x8){l0[0], l0[1], l0[2], l0[3], h0[0], h0[1], h0[2], h0[3]}, o[d0], 0, 0, 0);   \
        o[d0] = __builtin_amdgcn_mfma_f32_32x32x16_bf16(pa1, (bf16x8){l1[0], l1[1], l1[2], l1[3], h1[0], h1[1], h1[2], h1[3]}, o[d0], 0, 0, 0);   \
        o[d0] = __builtin_amdgcn_mfma_f32_32x32x16_bf16(pa2, (bf16x8){l2[0], l2[1], l2[2], l2[3], h2[0], h2[1], h2[2], h2[3]}, o[d0], 0, 0, 0);   \
        o[d0] = __builtin_amdgcn_mfma_f32_32x32x16_bf16(pa3, (bf16x8){l3[0], l3[1], l3[2], l3[3], h3[0], h3[1], h3[2], h3[3]}, o[d0], 0, 0, 0); } while (0)
    PV_D0(0); PV_D0(1); PV_D0(2); PV_D0(3);
#undef PV_D0
#undef TRRD
}

struct BlockRef {
    const bf16_t* Q; const bf16_t* K; const bf16_t* V; bf16_t* O;
    const bf16_t* QR; const bf16_t* KR;
    const float* POS; float* LSE;
    int qs, ks, vs, os, ps, ls;
    int P0, skv, W; float slopeS;
};
template <int MODE> struct Seam {
    bf16x8 qr[8]; bf16x8 qrr[4];
    bf16x8 st_v0, st_v1; float st_pos;
};
__device__ __forceinline__ int swa_jlo(int P0, int W) { const int lowk = P0 - W + 1; return lowk > 0 ? lowk / KVBLK : 0; }
#define VMW() asm volatile("s_waitcnt vmcnt(0)" ::: "memory")
#define VMWN(n) asm volatile("s_waitcnt vmcnt(%0)" :: "i"(n) : "memory")
__device__ __forceinline__ bf16x8 gld8(const bf16_t* base, size_t uoff, unsigned lboff) { return *reinterpret_cast<const bf16x8*>((const char*)(base + uoff) + lboff); }
__device__ __forceinline__ void glds16(const bf16_t* base, size_t uoff, unsigned lboff, LAS unsigned char* dst) {
    __builtin_amdgcn_global_load_lds((const unsigned*)((const char*)(base + uoff) + lboff), (LAS unsigned*)dst, 16, 0, 0); }
#define SLOAD_H(R, k0, kbuf) do { const unsigned lv0_ = (unsigned)(sr * (R).vs + sc) * 2u, lkd_ = (unsigned)(sr * (R).ks + (((tid & 15) ^ (sr & 7)) << 3)) * 2u;                \
                         S.st_v0 = gld8((R).V, (size_t)(k0) * (R).vs, lv0_); S.st_v1 = gld8((R).V, (size_t)((k0) + 32) * (R).vs, lv0_);                                   \
                         glds16((R).K, (size_t)(k0) * (R).ks, lkd_, ldsl + OFF_K + (kbuf) * SHM_K + wid * 1024);                                                          \
                         glds16((R).K, (size_t)((k0) + 32) * (R).ks, lkd_, ldsl + OFF_K + (kbuf) * SHM_K + 8192 + wid * 1024);                                            \
                         if constexpr (C::ROPE) glds16((R).KR, (size_t)(k0) * 64, (unsigned)(krr * 64 + ((krc ^ (krr & 7)) << 3)) * 2u, ldsl + OFF_KR + (kbuf) * SHM_KR + wid * 1024); \
                         if constexpr (C::ALIBI) { if (tid < 64) S.st_pos = (R).POS[(size_t)((k0) + tid) * (R).ps]; } } while (0)
#define SWRITE_HK(bf) do { if constexpr (C::ALIBI) { if (tid < 64) *(float*)(lds + OFF_POS + (bf) * 256 + tid * 4) = S.st_pos; } } while (0)
#define SWRITE_HV(bf) do { *(bf16x8*)(lds + OFF_V + (bf) * SHM_V + vst0) = S.st_v0; *(bf16x8*)(lds + OFF_V + (bf) * SHM_V + vst0 + 8192) = S.st_v1; } while (0)
#define SWRITE_H(bf) do { SWRITE_HV(bf); SWRITE_HK(bf); } while (0)
#define QLOAD(R) do { const size_t qu_ = (size_t)((R).P0 + wid * QBLK) * (R).qs; const unsigned ql_ = (unsigned)(r32 * (R).qs + hi * 8) * 2u;                          \
                      _Pragma("unroll") for (int d0 = 0; d0 < 8; ++d0) S.qr[d0] = gld8((R).Q, qu_ + d0 * 16, ql_);                                                       \
                      if constexpr (C::ROPE) { _Pragma("unroll") for (int d0 = 0; d0 < 4; ++d0) S.qrr[d0] = gld8((R).QR, qu_ + d0 * 16, ql_); } } while (0)

#define QRWRITE() do { if constexpr (C::ROPE) { _Pragma("unroll") for (int d0 = 0; d0 < 4; ++d0) *(bf16x8*)(lds + OFF_QR + ((wid * 4 + d0) * 64 + lane) * 16) = S.qrr[d0]; } } while (0)
template <int MODE>
__device__ __forceinline__ void attn_prime(const BlockRef& cur, char* lds, LAS unsigned char* ldsl, Seam<MODE>& S) {
    using C = Cfg<MODE>;
    const int tid = ltid(), wid = __builtin_amdgcn_readfirstlane(tid >> 6), lane = tid & 63, r32 = lane & 31, hi = lane >> 5;
    const int sr = tid >> 4, sc = (tid & 15) * 8, kws = KSWZ(sr, sc * 2);
    const int krr = tid >> 3, krc = tid & 7, krw = KRSWZ(krr, krc);
    const int kb0 = swa_jlo(cur.P0, cur.W) * KVBLK;
    QLOAD(cur);
    SLOAD_H(cur, kb0, 0); VMW(); SWRITE_HK(0); QRWRITE();
    __syncthreads();
}
template <int MODE>
__device__ __forceinline__ void attn_block(const BlockRef& cur, const BlockRef& nxt, char* lds, LAS unsigned char* ldsl, Seam<MODE>& S) {
    using C = Cfg<MODE>;
    constexpr bool SK = C::SK; constexpr float SCALE = C::SCALE;
    const int tid = ltid(), wid = __builtin_amdgcn_readfirstlane(tid >> 6), lane = tid & 63, r32 = lane & 31, hi = lane >> 5;
    const int W = cur.W;
    const int j_lo = swa_jlo(cur.P0, W);
    int j_hi = (cur.P0 + QB - 1) / KVBLK + 1; if (j_hi > cur.skv / KVBLK) j_hi = cur.skv / KVBLK;
    const int NT = j_hi - j_lo;
    const int kbn = swa_jlo(nxt.P0, nxt.W) * KVBLK;
    const int qlo = cur.P0 + wid * QBLK, qm = qlo + r32 - 4 * hi;
    float* ws = (float*)(lds + OFF_WS) + wid * 64; float* li_l = ws, * al_l = ws + 32;
    float m_reg = -1e30f, l_reg = 0; f32x16 o[4] = {};
    const int sr = tid >> 4, sc = (tid & 15) * 8, vst0 = v_st(sr, sc), kws = KSWZ(sr, sc * 2);
    const int krr = tid >> 3, krc = tid & 7, krw = KRSWZ(krr, krc);
    const int vb0 = (int)(uintptr_t)(lds) + v_rd_base(lane);
    const char* qrl = lds + OFF_QR + (wid * 4 * 64 + lane) * 16;
    float posq = 0.f;
    if constexpr (C::ALIBI) posq = cur.POS[(size_t)(qlo + r32) * cur.ps];
    const float slopeS = cur.slopeS;
#define RESC(a) do { if (__any((a) < 1.f)) { if (hi == 0) al_l[r32] = (a); asm volatile("s_waitcnt lgkmcnt(0)" ::: "memory");              \
                     _Pragma("unroll") for (int d_ = 0; d_ < 4; ++d_) _Pragma("unroll") for (int r = 0; r < 16; ++r) o[d_][r] *= al_l[crow(r, hi)]; } } while (0)
#define KBASE(t) ((j_lo + (t)) * KVBLK)
#define ACT(t) (KBASE(t) <= qlo + QBLK - 1 && KBASE(t) + KVBLK - 1 >= qlo - W + 1)
#define MASKT(P0_, P1_, t, BUF) do { const int kb_ = KBASE(t);                                                                               \
        if constexpr (C::ALIBI) { if (!SK || ACT(t)) { const f32x4* pp = (const f32x4*)(lds + OFF_POS + (BUF) * 256) + hi;                 \
            _Pragma("unroll") for (int g_ = 0; g_ < 4; ++g_) { const f32x4 k0_ = pp[2 * g_], k1_ = pp[2 * g_ + 8];                           \
                _Pragma("unroll") for (int e_ = 0; e_ < 4; ++e_) { P0_[4 * g_ + e_] = fmaf(-slopeS, fabsf(posq - k0_[e_]), P0_[4 * g_ + e_]); \
                                                                   P1_[4 * g_ + e_] = fmaf(-slopeS, fabsf(posq - k1_[e_]), P1_[4 * g_ + e_]); } } } } \
        if ((!SK || ACT(t)) && (kb_ + KVBLK - 1 > qlo || kb_ <= qlo + QBLK - 1 - W)) mask_tile(P0_, P1_, qm - kb_, (unsigned)W); } while (0)
    f32x16 p0, p1; float mn, al; bf16x8 pa0, pa1, pa2, pa3;
    SWRITE_HV(0); SBAR();
    if (NT > 1) { SLOAD_H(cur, KBASE(1), 1); }
    __syncthreads();
#define STEP(t, BUF) do {                                                                                                      \
        SBAR(); qkt<BUF, SK, C::ROPE>(p0, p1, lds, r32, hi, S.qr, qrl, ACT(t));                                              \
        MASKT(p0, p1, (t), BUF); partialSM<MODE>(p0, p1, m_reg, mn, al); RESC(al);                                             \
        finishSM(p0, p1, al, l_reg, pa0, pa1, pa2, pa3); SBAR();                                                               \
        pv_tile<BUF, SK>(o, vb0, pa0, pa1, pa2, pa3, ACT(t)); SBAR();                                                          \
        if ((t) + 1 < NT) { VMW(); SWRITE_H((BUF) ^ 1); }                                                                      \
        __syncthreads();                                                                                                       \
        if ((t) + 2 < NT) { SLOAD_H(cur, KBASE((t) + 2), BUF); } SBAR(); } while (0)
    for (int t = 0; t + 1 < NT; t += 2) { STEP(t, 0); STEP(t + 1, 1); }
    if (NT & 1) { STEP(NT - 1, 0); }
    SLOAD_H(nxt, kbn, 0); SBAR();
    QLOAD(nxt);
    SBAR();
    if (hi == 0) li_l[r32] = l_reg; asm volatile("s_waitcnt lgkmcnt(0)" ::: "memory");
    if constexpr (C::ALIBI) { if (hi == 0) cur.LSE[(size_t)(qlo + r32) * cur.ls] = m_reg * SCALE + __logf(l_reg); }
    float rli[16];
#pragma unroll
    for (int r = 0; r < 16; ++r) rli[r] = __builtin_amdgcn_rcpf(li_l[crow(r, hi)]);
    bf16_t* Ow = cur.O + (size_t)qlo * cur.os;
    const unsigned ol_ = (unsigned)(4 * hi * cur.os + r32) * 2u;
#pragma unroll
    for (int r = 0; r < 16; ++r) { const size_t ou_ = (size_t)((r & 3) + 8 * (r >> 2)) * cur.os;
#pragma unroll
        for (int d0 = 0; d0 < 4; ++d0) { const float v = o[d0][r] * rli[r];
            const float vn = __shfl_xor(v, 1);
            if ((r32 & 1) == 0) *(unsigned*)((char*)(Ow + ou_ + d0 * 32) + ol_) = cvtpk(v, vn); } }
    VMW(); SWRITE_HK(0); QRWRITE();
    __syncthreads();
#undef RESC
#undef KBASE
#undef ACT
#undef MASKT
#undef STEP
}

template <int MODE>
__device__ __forceinline__ void attn_block_pipe(const BlockRef& cur, const BlockRef& nxt, char* lds, LAS unsigned char* ldsl, Seam<MODE>& S) {
    using C = Cfg<MODE>;
    constexpr bool SK = C::SK; constexpr float SCALE = C::SCALE;
    const int tid = ltid(), wid = __builtin_amdgcn_readfirstlane(tid >> 6), lane = tid & 63, r32 = lane & 31, hi = lane >> 5;
    const int W = cur.W;
    const int j_lo = swa_jlo(cur.P0, W);
    int j_hi = (cur.P0 + QB - 1) / KVBLK + 1; if (j_hi > cur.skv / KVBLK) j_hi = cur.skv / KVBLK;
    const int NT = j_hi - j_lo;
    const int kbn = swa_jlo(nxt.P0, nxt.W) * KVBLK;
    const int qlo = cur.P0 + wid * QBLK, qm = qlo + r32 - 4 * hi;
    float* ws = (float*)(lds + OFF_WS) + wid * 64; float* li_l = ws, * al_l = ws + 32;
    float m_reg = -1e30f, l_reg = 0; f32x16 o[4] = {};
    const int sr = tid >> 4, sc = (tid & 15) * 8, vst0 = v_st(sr, sc), kws = KSWZ(sr, sc * 2);
    const int krr = tid >> 3, krc = tid & 7, krw = KRSWZ(krr, krc);
    const int vb0 = (int)(uintptr_t)(lds) + v_rd_base(lane);
    const char* qrl = lds + OFF_QR + (wid * 4 * 64 + lane) * 16;
    float posq = 0.f;
    if constexpr (C::ALIBI) posq = cur.POS[(size_t)(qlo + r32) * cur.ps];
    const float slopeS = cur.slopeS;
#define RESC(a) do { if (__any((a) < 1.f)) { if (hi == 0) al_l[r32] = (a); asm volatile("s_waitcnt lgkmcnt(0)" ::: "memory");              \
                     _Pragma("unroll") for (int d_ = 0; d_ < 4; ++d_) _Pragma("unroll") for (int r = 0; r < 16; ++r) o[d_][r] *= al_l[crow(r, hi)]; } } while (0)
#define KBASE(t) ((j_lo + (t)) * KVBLK)
#define ACT(t) (KBASE(t) <= qlo + QBLK - 1 && KBASE(t) + KVBLK - 1 >= qlo - W + 1)
#define MASKT(P0_, P1_, t, BUF) do { const int kb_ = KBASE(t);                                                                               \
        if constexpr (C::ALIBI) { if (!SK || ACT(t)) { const f32x4* pp = (const f32x4*)(lds + OFF_POS + (BUF) * 256) + hi;                 \
            _Pragma("unroll") for (int g_ = 0; g_ < 4; ++g_) { const f32x4 k0_ = pp[2 * g_], k1_ = pp[2 * g_ + 8];                           \
                _Pragma("unroll") for (int e_ = 0; e_ < 4; ++e_) { P0_[4 * g_ + e_] = fmaf(-slopeS, fabsf(posq - k0_[e_]), P0_[4 * g_ + e_]); \
                                                                   P1_[4 * g_ + e_] = fmaf(-slopeS, fabsf(posq - k1_[e_]), P1_[4 * g_ + e_]); } } } } \
        if ((!SK || ACT(t)) && (kb_ + KVBLK - 1 > qlo || kb_ <= qlo + QBLK - 1 - W)) mask_tile(P0_, P1_, qm - kb_, (unsigned)W); } while (0)
    constexpr int NQL = C::ROPE ? 12 : 8;
#define SEAM_K0() do { VMWN(NQL); SWRITE_HK(0); SBAR(); } while (0)
    f32x16 pA0, pA1, pB0, pB1; float mnA, mnB, alA, alB; bf16x8 pa0, pa1, pa2, pa3;
    SWRITE_HV(0); SBAR();
    if (NT > 1) { SLOAD_H(cur, KBASE(1), 1); }
    SBAR(); qkt<0, SK, C::ROPE>(pA0, pA1, lds, r32, hi, S.qr, qrl, ACT(0));
    MASKT(pA0, pA1, 0, 0); partialSM<MODE>(pA0, pA1, m_reg, mnA, alA);
    if (NT > 1) { VMW(); SWRITE_H(1); }
    __syncthreads();
#define HALF_STEP(PX0, PX1, mnX, alX, PY0, PY1, alY, t, KB, VB, SB) do {                                                      \
        SBAR(); qkt<KB, SK, C::ROPE>(PX0, PX1, lds, r32, hi, S.qr, qrl, ACT(t));                                           \
        finishSM(PY0, PY1, alY, l_reg, pa0, pa1, pa2, pa3); SBAR();                                                           \
        if ((t) + 1 < NT) { SLOAD_H(cur, KBASE((t) + 1), SB); SBAR(); }                                                           \
        pv_tile<VB, SK>(o, vb0, pa0, pa1, pa2, pa3, ACT((t) - 1)); MASKT(PX0, PX1, (t), KB); partialSM<MODE>(PX0, PX1, m_reg, mnX, alX); \
        __syncthreads();                                                                                                      \
        if ((t) + 1 < NT) { VMW(); SWRITE_H(SB); }                                                                            \
        RESC(alX); __syncthreads(); } while (0)
    for (int t = 1; t + 1 < NT; t += 2) {
        HALF_STEP(pB0, pB1, mnB, alB, pA0, pA1, alA, t, 1, 0, 0);
        HALF_STEP(pA0, pA1, mnA, alA, pB0, pB1, alB, t + 1, 0, 1, 1);
    }
    const bool even = (NT & 1) == 0;
    if (even) { SBAR(); qkt<1, SK, C::ROPE>(pB0, pB1, lds, r32, hi, S.qr, qrl, ACT(NT - 1)); SBAR(); }
    SLOAD_H(nxt, kbn, 0); SBAR();
    QLOAD(nxt);
    SBAR();
    finishSM(pA0, pA1, alA, l_reg, pa0, pa1, pa2, pa3); SBAR();
    pv_tile<0, SK>(o, vb0, pa0, pa1, pa2, pa3, ACT(even ? NT - 2 : NT - 1));
    if (even) { MASKT(pB0, pB1, NT - 1, 1); partialSM<MODE>(pB0, pB1, m_reg, mnB, alB); __syncthreads(); RESC(alB);
        finishSM(pB0, pB1, alB, l_reg, pa0, pa1, pa2, pa3); SBAR(); pv_tile<1, SK>(o, vb0, pa0, pa1, pa2, pa3, ACT(NT - 1)); }
    SBAR(); SEAM_K0();
    if (hi == 0) li_l[r32] = l_reg; asm volatile("s_waitcnt lgkmcnt(0)" ::: "memory");
    if constexpr (C::ALIBI) { if (hi == 0) cur.LSE[(size_t)(qlo + r32) * cur.ls] = m_reg * SCALE + __logf(l_reg); }
    float rli[16];
#pragma unroll
    for (int r = 0; r < 16; ++r) rli[r] = __builtin_amdgcn_rcpf(li_l[crow(r, hi)]);
    bf16_t* Ow = cur.O + (size_t)qlo * cur.os;
    const unsigned ol_ = (unsigned)(4 * hi * cur.os + r32) * 2u;
#pragma unroll
    for (int r = 0; r < 16; ++r) { const size_t ou_ = (size_t)((r & 3) + 8 * (r >> 2)) * cur.os;
#pragma unroll
        for (int d0 = 0; d0 < 4; ++d0) { const float v = o[d0][r] * rli[r];
            const float vn = __shfl_xor(v, 1);
            if ((r32 & 1) == 0) *(unsigned*)((char*)(Ow + ou_ + d0 * 32) + ol_) = cvtpk(v, vn); } }
    if constexpr (C::ROPE) { VMW(); QRWRITE(); }
    __syncthreads();
#undef RESC
#undef KBASE
#undef ACT
#undef MASKT
#undef SEAM_K0
#undef HALF_STEP
}
#undef VMW
#undef VMWN
#undef SLOAD_H
#undef SWRITE_HK
#undef SWRITE_HV
#undef SWRITE_H
#undef QLOAD
#undef QRWRITE
}
constexpr size_t MiB = 1u << 20;
constexpr size_t WS_CTL = 0, CTL_ZERO_BYTES = 1 * MiB;
constexpr size_t WS_SM = 1 * MiB;
constexpr size_t WS_MODV = WS_SM;
constexpr size_t WS_RQ = WS_SM + 128 * 1024, WS_RKV = WS_SM + 192 * 1024, WS_POSF = WS_SM + 256 * 1024, WS_CNT = WS_SM + 320 * 1024, WS_TILEE = WS_SM + 384 * 1024;
constexpr size_t WS_MODP = 2 * MiB;
constexpr size_t WS_COS = 4 * MiB, WS_SIN = 6 * MiB, WS_KR = 8 * MiB, WS_LOGIT = 10 * MiB, WS_EIDX = 14 * MiB, WS_EW = 14 * MiB + 512 * 1024;
constexpr size_t WS_STOK = 15 * MiB, WS_SDST = 16 * MiB, WS_SW = 17 * MiB, WS_LSE = 18 * MiB;
constexpr size_t WS_WG2 = 20 * MiB;
constexpr size_t WS_WIN = 150 * MiB, WS_WO = 166 * MiB, WS_WUQ = 174 * MiB, WS_WUKV = 176 * MiB, WS_WR = 177 * MiB;
constexpr size_t WS_WG1 = 178 * MiB;
constexpr size_t WS_H = 438 * MiB;
constexpr size_t WS_PROJ = 503 * MiB;
constexpr size_t WS_MIX = WS_PROJ;
constexpr size_t WS_QM = 631 * MiB, WS_KV = 679 * MiB, WS_OSWA = 743 * MiB, WS_OMLA = 839 * MiB;
constexpr size_t WS_YS = WS_WG1;
constexpr size_t WS_ACT = 760 * MiB;
constexpr size_t WS_END = 921 * MiB;
constexpr int YS_ROWS = 147456;
static_assert(WS_YS + (size_t)YS_ROWS * DM * 2 <= WS_ACT && WS_ACT + (size_t)MAX_SLOTS * 512 * 2 <= WS_END, "ws map");
static_assert(WS_WG2 + (size_t)NE1 * 2048 * 512 * 2 <= WS_WIN && WS_WG1 + (size_t)NE1 * 1024 * 2048 * 2 <= WS_H && WS_H + (size_t)(S_ + 256) * DM * 2 <= WS_PROJ, "ws map 2");
constexpr int CW_TMO = 0, CW_NT = 16, CW_BAR = 4096;

constexpr int RING_BYTES = 131072, LDSCTL_OFF = RING_BYTES, MISC_OFF = LDSCTL_OFF + 320, TILE_OFF = LDSCTL_OFF + 1024, LDS_BYTES = 147456;
static_assert(TILE_OFF + 2 * MAX_TILES * 4 <= LDS_BYTES, "lds map");

#define XB_TMO      128
#define XB_XCNT(j)  (256  + 64 * (j))
#define XB_XSUB(j)  (1280 + 64 * (j))
#define XB_XGEN(j)  (2304 + 64 * (j))
#define XB_TOP      3328
#define XB_TOPGEN   3392
#define XCD_BAR_WORDS 3456
#define XB_SPIN_CAP (1u << 18)
__device__ __forceinline__ unsigned xb_ld(unsigned* p)              { return __hip_atomic_load(p, __ATOMIC_RELAXED, __HIP_MEMORY_SCOPE_AGENT); }
__device__ __forceinline__ unsigned xb_add(unsigned* p, unsigned v) { return __hip_atomic_fetch_add(p, v, __ATOMIC_RELAXED, __HIP_MEMORY_SCOPE_AGENT); }
__device__ __forceinline__ unsigned xb_xcc_id() { return (unsigned)__builtin_amdgcn_s_getreg((3 << 11) | 20) & 0xFu; }
#define XB_SPIN(cond, bar) do { unsigned _sp = 0; while (cond) { __builtin_amdgcn_s_sleep(1); \
    if ((++_sp & 255u) == 0u) { if (xb_ld(&(bar)[XB_TMO])) break; if (_sp > XB_SPIN_CAP) { atomicAdd(&(bar)[XB_TMO], 1u); break; } } } } while (0)
struct XcdBarrier { unsigned* bar; unsigned x; volatile LAS unsigned* st; };
__device__ __forceinline__ XcdBarrier xcd_barrier_post(unsigned* bar, volatile LAS unsigned* st) {
    XcdBarrier b; b.bar = bar; b.x = xb_xcc_id(); b.st = st;
    if (threadIdx.x == 0) (void)xb_add(&bar[XB_XCNT(b.x)], 1u);
    return b;
}
__device__ __forceinline__ void xcd_barrier_complete(unsigned* bar, unsigned x, unsigned& nloc, unsigned& nx) {
    const unsigned G = gridDim.x * gridDim.y * gridDim.z;
    unsigned sum, cnt, mine, sp = 0u;
    for (;;) {
        sum = 0u; cnt = 0u; mine = 0u;
#pragma unroll
        for (unsigned j = 0; j < 16; ++j) { const unsigned c = xb_ld(&bar[XB_XCNT(j)]); sum += c; cnt += (c > 0u) ? 1u : 0u; mine = (j == x) ? c : mine; }
        if (sum == G) break;
        __builtin_amdgcn_s_sleep(1);
        if ((++sp & 255u) == 0u) { if (xb_ld(&bar[XB_TMO])) break; if (sp > XB_SPIN_CAP) { atomicAdd(&bar[XB_TMO], 1u); break; } }
    }
    nloc = mine > 0u ? mine : 1u; nx = cnt > 0u ? cnt : 1u;
}
__device__ __forceinline__ void xcd_barrier(const XcdBarrier& b) {
    asm volatile("s_waitcnt vmcnt(0)" ::: "memory");
    __syncthreads();
    if (threadIdx.x == 0) {
        unsigned* bar = b.bar;
        __builtin_amdgcn_s_waitcnt(0);
        unsigned nloc = b.st[0], nx = b.st[1];
        if (nloc == 0u) { xcd_barrier_complete(bar, b.x, nloc, nx); b.st[0] = nloc; b.st[1] = nx; }
        const unsigned old = xb_add(&bar[XB_XSUB(b.x)], 1u);
        const unsigned gen = old / nloc;
        if (old + 1u == (gen + 1u) * nloc) {
            __builtin_amdgcn_fence(__ATOMIC_RELEASE, "agent");
            asm volatile("s_waitcnt vmcnt(0)" ::: "memory");
            const unsigned og = xb_add(&bar[XB_TOP], 1u);
            const unsigned tg = og / nx;
            if (og + 1u == (tg + 1u) * nx) xb_add(&bar[XB_TOPGEN], 1u);
            else XB_SPIN(xb_ld(&bar[XB_TOPGEN]) == tg, bar);
            __builtin_amdgcn_fence(__ATOMIC_ACQUIRE, "agent");
            xb_add(&bar[XB_XGEN(b.x)], 1u);
            asm volatile("s_waitcnt vmcnt(0)" ::: "memory");
        } else {
            XB_SPIN(xb_ld(&bar[XB_XGEN(b.x)]) == gen, bar);
            __builtin_amdgcn_fence(__ATOMIC_ACQUIRE, "agent");
            asm volatile("s_waitcnt vmcnt(0)" ::: "memory");
        }
    }
    __syncthreads();
}

constexpr int NWAVES = 8;
struct Frame {
    LAS unsigned char* lds; char* ldsg;
    volatile LAS unsigned* MISC;
    unsigned* ctl;
    int tid, lane, wave, G, bid;
    unsigned char* ws;
    const float *x, *c, *norm_attn_g, *w_ada, *b_ada, *w_in, *g_q, *w_uq, *g_kv, *w_ukv, *g_out_swa, *g_out_mla, *w_o, *norm_ffn_g, *w_router, *router_bias;
    const float *w_exp_gate, *w_exp_up, *w_exp_down, *w_sh_gate, *w_sh_up, *w_sh_down, *final_norm_g;
    const int* positions;
    float* out;
};
#define LDS_WAIT() asm volatile("s_waitcnt lgkmcnt(0)" ::: "memory")
#define FRESH(F) do { (F).tid = ltid(); (F).lane = (F).tid & 63; (F).wave = __builtin_amdgcn_readfirstlane((F).tid >> 6); } while (0)
#define WSP(T, off) ((T*)(F.ws + (off)))

__device__ __forceinline__ void transpose_item(const float* W, int ldw, int k0, bf16_t* dst, int Kd, const float* kscale, bool zero, LAS float* scr, int lane) {
    if (!zero) {
        float v[32];
#pragma unroll
        for (int i = 0; i < 32; ++i) { const int kk = 2 * i + (lane >> 5); v[i] = W[(size_t)(k0 + kk) * ldw + (lane & 31)]; }
        if (kscale) {
#pragma unroll
            for (int i = 0; i < 32; ++i) v[i] *= kscale[k0 + 2 * i + (lane >> 5)]; }
#pragma unroll
        for (int i = 0; i < 32; ++i) { const int kk = 2 * i + (lane >> 5); scr[kk * 33 + (lane & 31)] = v[i]; }
    }
    LDS_WAIT(); asm volatile("" ::: "memory");
    const int c = lane & 7;
#pragma unroll
    for (int j = 0; j < 4; ++j) { const int n = (lane >> 3) + 8 * j; const LAS float* s = scr + (8 * c) * 33 + n;
        u32x4 o;
        if (zero) { o = (u32x4){0u, 0u, 0u, 0u}; }
        else { o.x = pk2(s[0 * 33], s[1 * 33]); o.y = pk2(s[2 * 33], s[3 * 33]); o.z = pk2(s[4 * 33], s[5 * 33]); o.w = pk2(s[6 * 33], s[7 * 33]); }
        *(u32x4*)(dst + (size_t)n * Kd + k0 + 8 * c) = o; }
    LDS_WAIT(); asm volatile("" ::: "memory");
}
constexpr int I_WIN = 32 * 128, I_WUQ = 8 * 48, I_WUKV = 4 * 64, I_WO = 32 * 64, I_WR = 32 * 8, I_G1 = NE1 * 1024, I_G2 = NE1 * 512;
constexpr int I_TOTAL = I_WIN + I_WUQ + I_WUKV + I_WO + I_WR + I_G1 + I_G2;
constexpr int GEMV_ITEMS = 48 * 32;

__device__ __forceinline__ void convert_item(Frame& F, int it, LAS float* scr) {
    int r = it; const int lane = F.lane;
    if (r < I_WIN) { const int kb = r / 128, nb = r % 128; transpose_item(F.w_in + nb * 32, 3904, kb * 64, WSP(bf16_t, WS_WIN) + (size_t)nb * 32 * 2048, 2048, nullptr, nb >= 122, scr, lane); return; } r -= I_WIN;
    if (r < I_WUQ) { const int kb = r / 48, nb = r % 48, pn = nb >> 3, p0 = (nb & 7) * 32; int col;
        if (pn < 4) col = (2 * pn + (p0 >> 7)) * 192 + (p0 & 127);
        else if (p0 < 128) col = (4 * (pn - 4) + (p0 >> 5)) * 192 + 128;
        else col = (4 * (pn - 4) + ((p0 - 128) >> 5)) * 192 + 160;
        transpose_item(F.w_uq + col, 1536, kb * 64, WSP(bf16_t, WS_WUQ) + (size_t)nb * 32 * 512, 512, F.g_q, false, scr, lane); return; } r -= I_WUQ;
    if (r < I_WUKV) { const int kb = r / 64, nb = r % 64; transpose_item(F.w_ukv + nb * 32, 2048, kb * 64, WSP(bf16_t, WS_WUKV) + (size_t)nb * 32 * 256, 256, F.g_kv, false, scr, lane); return; } r -= I_WUKV;
    if (r < I_WO) { const int kb = r / 64, nb = r % 64; transpose_item(F.w_o + nb * 32, 2048, kb * 64, WSP(bf16_t, WS_WO) + (size_t)nb * 32 * 2048, 2048, nullptr, false, scr, lane); return; } r -= I_WO;
    if (r < I_WR) { const int kb = r / 8, nb = r % 8; transpose_item(F.w_router + (nb < 2 ? nb * 32 : 0), 64, kb * 64, WSP(bf16_t, WS_WR) + (size_t)nb * 32 * 2048, 2048, nullptr, nb >= 2, scr, lane); return; } r -= I_WR;
    if (r < I_G1) { const int e = r >> 10, r2 = r & 1023, kb = r2 >> 5, nb = r2 & 31, pn = nb >> 3, p0 = (nb & 7) * 32;
        const float* src = (p0 < 128) ? (e < NEXP ? F.w_exp_gate + (size_t)e * 2048 * 512 : F.w_sh_gate) + 128 * pn + p0
                                      : (e < NEXP ? F.w_exp_up + (size_t)e * 2048 * 512 : F.w_sh_up) + 128 * pn + (p0 - 128);
        transpose_item(src, 512, kb * 64, WSP(bf16_t, WS_WG1) + ((size_t)e * 1024 + nb * 32) * 2048, 2048, nullptr, false, scr, lane); return; } r -= I_G1;
    { const int e = r >> 9, r2 = r & 511, kb = r2 >> 6, nb = r2 & 63;
        const float* src = (e < NEXP ? F.w_exp_down + (size_t)e * 512 * 2048 : F.w_sh_down) + nb * 32;
        transpose_item(src, 2048, kb * 64, WSP(bf16_t, WS_WG2) + ((size_t)e * 2048 + nb * 32) * 512, 512, nullptr, false, scr, lane); }
}
__device__ __forceinline__ float silu_f(float v) { return v / (1.f + __expf(-v)); }
__device__ __forceinline__ void p0_prologue(Frame& F) {
    LAS float* scr = (LAS float*)(F.lds + F.wave * 16384);
    const int gw = F.bid * NWAVES + F.wave, NGW = F.G * NWAVES;
    for (int it = gw; it < GEMV_ITEMS; it += NGW) {
        const int ch = it % 48, kr = it / 48, col = ch * 256 + F.lane * 4;
        f32x4 a = {0.f, 0.f, 0.f, 0.f};
#pragma unroll 8
        for (int k = 0; k < 64; ++k) { const int kk = kr * 64 + k; const float s = silu_f(F.c[kk]); a += s * *(const f32x4*)(F.w_ada + (size_t)kk * 12288 + col); }
        *(f32x4*)(WSP(float, WS_MODP) + (size_t)kr * 12288 + col) = a;
    }
    for (int it = gw; it < I_TOTAL; it += NGW) convert_item(F, it, scr);
}
__device__ __forceinline__ void p1_mod(Frame& F) {
    const int g = F.bid * 512 + F.tid, NG = F.G * 512;
    for (int i = g; i < 12288; i += NG) {
        float v = F.b_ada[i];
        for (int kr = 0; kr < 32; ++kr) v += WSP(float, WS_MODP)[(size_t)kr * 12288 + i];
        const int chunk = i >> 11, col = i & 2047; float* mv = WSP(float, WS_MODV);
        if (chunk == 0) mv[1 * 2048 + col] = v;
        else if (chunk == 1) mv[0 * 2048 + col] = F.norm_attn_g[col] * (1.f + v);
        else if (chunk == 2) mv[2 * 2048 + col] = v;
        else if (chunk == 3) mv[4 * 2048 + col] = v;
        else if (chunk == 4) mv[3 * 2048 + col] = F.norm_ffn_g[col] * (1.f + v);
        else mv[5 * 2048 + col] = v;
    }
    for (int i = g; i < S_; i += NG) WSP(float, WS_POSF)[i] = (float)F.positions[i];
    for (int i = g; i < 1024; i += NG) WSP(unsigned, WS_H)[(size_t)S_ * 1024 + i] = 0u;
}
__device__ __forceinline__ void norm_mod_row(const float* xrow, const float* A, const float* B, bf16_t* orow, int lane) {
    const f32x4* xr = (const f32x4*)xrow + lane;
    f32x4 v[8]; float s = 0.f;
#pragma unroll
    for (int j = 0; j < 8; ++j) { v[j] = xr[64 * j]; s += (v[j].x * v[j].x + v[j].y * v[j].y) + (v[j].z * v[j].z + v[j].w * v[j].w); }
    const float rstd = 1.f / sqrtf(wave_sum(s) * (1.f / DM) + EPS_);
    unsigned long long* o8 = (unsigned long long*)orow + lane;
#pragma unroll
    for (int j = 0; j < 8; ++j) { const f32x4 a = ((const f32x4*)A)[lane + 64 * j], b = ((const f32x4*)B)[lane + 64 * j]; const f32x4 h = v[j] * rstd * a + b;
        o8[64 * j] = (unsigned long long)pk2(h.x, h.y) | ((unsigned long long)pk2(h.z, h.w) << 32); }
}
__device__ __forceinline__ void p3_prep(Frame& F) {
    const int gw = F.bid * NWAVES + F.wave, NGW = F.G * NWAVES, lane = F.lane;
    for (int t = gw; t < S_; t += NGW) {
        const bf16_t* pr = WSP(bf16_t, WS_PROJ) + (size_t)t * D_INP;
        { const u32x4 w = *(const u32x4*)(pr + 3072 + 8 * lane); float s = 0.f;
#pragma unroll
          for (int i = 0; i < 4; ++i) { const float a = bf_lo(w[i]), b = bf_hi(w[i]); s += a * a + b * b; }
          s = wave_sum(s); if (lane == 0) WSP(float, WS_RQ)[t] = 1.f / sqrtf(s * (1.f / 512.f) + EPS_); }
        { float s = 0.f; if (lane < 32) { const u32x4 w = *(const u32x4*)(pr + 3584 + 8 * lane);
#pragma unroll
              for (int i = 0; i < 4; ++i) { const float a = bf_lo(w[i]), b = bf_hi(w[i]); s += a * a + b * b; } }
          s = wave_sum(s); if (lane == 0) WSP(float, WS_RKV)[t] = 1.f / sqrtf(s * (1.f / 256.f) + EPS_); }
        if (lane < 32) {
            const float x1 = __builtin_bit_cast(float, (unsigned)pr[3840 + lane] << 16), x2 = __builtin_bit_cast(float, (unsigned)pr[3872 + lane] << 16);
            const float inv = powf(10000.f, -(float)lane / 32.f); const float ang = (float)F.positions[t] * inv;
            float sn, cs; sincosf(ang, &sn, &cs);
            WSP(float, WS_COS)[(size_t)t * 32 + lane] = cs; WSP(float, WS_SIN)[(size_t)t * 32 + lane] = sn;
            bf16_t* kr = WSP(bf16_t, WS_KR) + (size_t)t * 64;
            kr[lane] = (bf16_t)f2bf(x1 * cs - x2 * sn); kr[32 + lane] = (bf16_t)f2bf(x2 * cs + x1 * sn);
        }
    }
}
__device__ __forceinline__ void p6_mix(Frame& F) {
    const int gw = F.bid * NWAVES + F.wave, NGW = F.G * NWAVES, lane = F.lane;
    for (int t = gw; t < S_; t += NGW) {
        const int h = lane >> 3; float ls[3], mx = -1e30f;
#pragma unroll
        for (int p = 0; p < 3; ++p) { ls[p] = WSP(float, WS_LSE)[((size_t)p * S_ + t) * 8 + h]; mx = fmaxf(mx, ls[p]); }
        float al[3], sa = 0.f;
#pragma unroll
        for (int p = 0; p < 3; ++p) { al[p] = __expf(ls[p] - mx); sa += al[p]; }
        const float isa = 1.f / sa; float o[16];
#pragma unroll
        for (int i = 0; i < 16; ++i) o[i] = 0.f;
#pragma unroll
        for (int p = 0; p < 3; ++p) { const float a = al[p] * isa; const u32x4* src = (const u32x4*)(WSP(bf16_t, WS_OSWA) + ((size_t)p * S_ + t) * 1024 + 16 * lane);
#pragma unroll
            for (int q = 0; q < 2; ++q) { const u32x4 w = src[q];
#pragma unroll
                for (int i = 0; i < 4; ++i) { o[q * 8 + 2 * i] += a * bf_lo(w[i]); o[q * 8 + 2 * i + 1] += a * bf_hi(w[i]); } } }
        float ss = 0.f;
#pragma unroll
        for (int i = 0; i < 16; ++i) ss += o[i] * o[i];
        float rstd = 1.f / sqrtf(wave_sum(ss) * (1.f / 1024.f) + EPS_);
        bf16_t* mrow = WSP(bf16_t, WS_MIX) + (size_t)t * DM;
        { u32x4 w0, w1; const float* gg = F.g_out_swa + 16 * lane;
          w0.x = pk2(o[0] * rstd * gg[0], o[1] * rstd * gg[1]); w0.y = pk2(o[2] * rstd * gg[2], o[3] * rstd * gg[3]); w0.z = pk2(o[4] * rstd * gg[4], o[5] * rstd * gg[5]); w0.w = pk2(o[6] * rstd * gg[6], o[7] * rstd * gg[7]);
          w1.x = pk2(o[8] * rstd * gg[8], o[9] * rstd * gg[9]); w1.y = pk2(o[10] * rstd * gg[10], o[11] * rstd * gg[11]); w1.z = pk2(o[12] * rstd * gg[12], o[13] * rstd * gg[13]); w1.w = pk2(o[14] * rstd * gg[14], o[15] * rstd * gg[15]);
          *(u32x4*)(mrow + 16 * lane) = w0; *(u32x4*)(mrow + 16 * lane + 8) = w1; }
        { const u32x4* src = (const u32x4*)(WSP(bf16_t, WS_OMLA) + (size_t)t * 1024 + 16 * lane);
#pragma unroll
          for (int q = 0; q < 2; ++q) { const u32x4 w = src[q];
#pragma unroll
              for (int i = 0; i < 4; ++i) { o[q * 8 + 2 * i] = bf_lo(w[i]); o[q * 8 + 2 * i + 1] = bf_hi(w[i]); } } }
        ss = 0.f;
#pragma unroll
        for (int i = 0; i < 16; ++i) ss += o[i] * o[i];
        rstd = 1.f / sqrtf(wave_sum(ss) * (1.f / 1024.f) + EPS_);
        { u32x4 w0, w1; const float* gg = F.g_out_mla + 16 * lane;
          w0.x = pk2(o[0] * rstd * gg[0], o[1] * rstd * gg[1]); w0.y = pk2(o[2] * rstd * gg[2], o[3] * rstd * gg[3]); w0.z = pk2(o[4] * rstd * gg[4], o[5] * rstd * gg[5]); w0.w = pk2(o[6] * rstd * gg[6], o[7] * rstd * gg[7]);
          w1.x = pk2(o[8] * rstd * gg[8], o[9] * rstd * gg[9]); w1.y = pk2(o[10] * rstd * gg[10], o[11] * rstd * gg[11]); w1.z = pk2(o[12] * rstd * gg[12], o[13] * rstd * gg[13]); w1.w = pk2(o[14] * rstd * gg[14], o[15] * rstd * gg[15]);
          *(u32x4*)(mrow + 1024 + 16 * lane) = w0; *(u32x4*)(mrow + 1024 + 16 * lane + 8) = w1; }
    }
}
__device__ __forceinline__ void p10_route(Frame& F) {
    LAS int* hist = (LAS int*)F.lds;
    if (F.tid < 64) hist[F.tid] = 0;
    __syncthreads();
    const int lane = F.lane;
    const float rb = F.router_bias[lane];
    for (int q = 0; q < 8; ++q) {
        const int t = F.bid * 64 + F.wave * 8 + q;
        const float logit = WSP(float, WS_LOGIT)[(size_t)t * 64 + lane];
        const float score = 1.f / (1.f + __expf(-logit)), choice = score + rb;
        float m1 = choice; m1 = fmaxf(m1, __shfl_xor(m1, 1)); m1 = fmaxf(m1, __shfl_xor(m1, 2)); m1 = fmaxf(m1, __shfl_xor(m1, 4));
        int cand = (choice == m1) ? (lane & 7) : 8; cand = min(cand, __shfl_xor(cand, 1)); cand = min(cand, __shfl_xor(cand, 2)); cand = min(cand, __shfl_xor(cand, 4));
        float m2 = ((lane & 7) == cand) ? -__builtin_inff() : choice; m2 = fmaxf(m2, __shfl_xor(m2, 1)); m2 = fmaxf(m2, __shfl_xor(m2, 2)); m2 = fmaxf(m2, __shfl_xor(m2, 4));
        const float gs = m1 + m2; const int g = lane >> 3; int rank = 0;
#pragma unroll
        for (int gg = 0; gg < 8; ++gg) { const float s = __shfl(gs, gg * 8); rank += (s > gs || (s == gs && gg < g)) ? 1 : 0; }
        const float masked = (rank < 4) ? choice : -1e30f;
        int r = 0;
        for (int e2 = 0; e2 < 64; ++e2) { const float v = __shfl(masked, e2); r += (v > masked || (v == masked && e2 < lane)) ? 1 : 0; }
        const bool sel = r < 8;
        const float ssum = wave_sum(sel ? score : 0.f);
        if (sel) { WSP(int, WS_EIDX)[(size_t)t * 8 + r] = lane; WSP(float, WS_EW)[(size_t)t * 8 + r] = score / ssum * 2.5f; atomicAdd((int*)&hist[lane], 1); }
    }
    __syncthreads();
    if (F.tid < 64) WSP(int, WS_CNT)[F.bid * 64 + F.tid] = hist[F.tid];
    __syncthreads();
}
__device__ __forceinline__ void p11_slots(Frame& F) {
    LAS int* tot = (LAS int*)F.lds;
    LAS int* pre = tot + 512;
    LAS int* total = pre + 512;
    LAS int* mypre = total + 80;
    LAS int* cursor = mypre + 64;
    LAS int* base = cursor + 64;
    LAS int* ntl = base + 80;
    const int tid = F.tid, b = F.bid;
    { const int e = tid & 63, part = tid >> 6; int sa = 0, sp = 0;
      for (int bb = part * 32; bb < part * 32 + 32; ++bb) { const int c = WSP(int, WS_CNT)[bb * 64 + e]; sa += c; if (bb < b) sp += c; }
      tot[part * 64 + e] = sa; pre[part * 64 + e] = sp; }
    __syncthreads();
    if (tid < 64) { int sa = 0, sp = 0;
        for (int p = 0; p < 8; ++p) { sa += tot[p * 64 + tid]; sp += pre[p * 64 + tid]; }
        total[tid] = sa; mypre[tid] = sp; cursor[tid] = 0; }
    __syncthreads();
    if (tid == 0) { int run = 0;
        for (int e = 0; e < NEXP; ++e) { base[e] = run * 256; const int n = (total[e] + 255) >> 8; ntl[e] = n; run += n; }
        base[NEXP] = run * 256; ntl[NEXP] = S_ / 256; total[NEXP] = S_; run += S_ / 256;
        if (b == 0) { F.ctl[CW_NT] = (unsigned)run; } }
    __syncthreads();
    if (b == 0 && tid < NE1) { int* te = WSP(int, WS_TILEE); te[tid] = base[tid] >> 8; te[128 + tid] = ntl[tid]; }
    { const int tl = tid >> 3, k = tid & 7, t = b * 64 + tl; const int e = WSP(int, WS_EIDX)[(size_t)t * 8 + k]; const float w = WSP(float, WS_EW)[(size_t)t * 8 + k];
      const int r = atomicAdd((int*)&cursor[e], 1); const int slot = base[e] + mypre[e] + r;
      WSP(int, WS_STOK)[slot] = t; WSP(int, WS_SDST)[(size_t)t * 8 + k] = slot; WSP(float, WS_SW)[slot] = w; }
    if (tid < 64) { const int t = b * 64 + tid, slot = base[NEXP] + t; WSP(int, WS_STOK)[slot] = t; WSP(float, WS_SW)[slot] = 1.f; }
    if (b < NEXP) { const int e = b; for (int s = base[e] + total[e] + tid; s < base[e] + ntl[e] * 256; s += 512) { WSP(int, WS_STOK)[s] = S_; WSP(float, WS_SW)[s] = 0.f; } }
    __syncthreads();
}
__device__ __forceinline__ u32x4 ldu16(const void* ubase, unsigned lboff) { return *(const u32x4*)((const char*)ubase + lboff); }
__device__ __forceinline__ f32x4 ldf16(const void* ubase, unsigned lboff) { return *(const f32x4*)((const char*)ubase + lboff); }
__device__ __forceinline__ void p14_final(Frame& F) {
    const int gw = F.bid * NWAVES + F.wave, NGW = F.G * NWAVES, lane = F.lane;
    const float* gf = WSP(float, WS_MODV) + 5 * 2048;
    const unsigned lb2 = (unsigned)lane * 16u, lb4 = (unsigned)lane * 32u;
    for (int t0 = gw; t0 < S_; t0 += NGW) {
        const int t = __builtin_amdgcn_readfirstlane(t0);
        float acc[32];
#pragma unroll
        for (int i = 0; i < 32; ++i) acc[i] = 0.f;
        const int* so = WSP(int, WS_SDST) + (size_t)t * 8;
#pragma unroll 2
        for (int k = 0; k < 8; ++k) { const bf16_t* yr = WSP(bf16_t, WS_YS) + (size_t)__builtin_amdgcn_readfirstlane(so[k]) * DM;
#pragma unroll
            for (int j = 0; j < 4; ++j) { const u32x4 w = ldu16(yr + 512 * j, lb2);
#pragma unroll
                for (int i = 0; i < 4; ++i) { acc[j * 8 + 2 * i] += bf_lo(w[i]); acc[j * 8 + 2 * i + 1] += bf_hi(w[i]); } } }
        float* xr = F.out + (size_t)t * DM; float ss = 0.f;
#pragma unroll
        for (int j = 0; j < 4; ++j) { const f32x4 a = ldf16(xr + 512 * j, lb4), b = ldf16(xr + 512 * j + 4, lb4);
            const f32x4 g0 = ldf16(gf + 512 * j, lb4), g1 = ldf16(gf + 512 * j + 4, lb4);
#pragma unroll
            for (int i = 0; i < 4; ++i) { acc[j * 8 + i] = a[i] + g0[i] * acc[j * 8 + i]; acc[j * 8 + 4 + i] = b[i] + g1[i] * acc[j * 8 + 4 + i]; } }
#pragma unroll
        for (int i = 0; i < 32; ++i) ss += acc[i] * acc[i];
        const float rstd = 1.f / sqrtf(wave_sum(ss) * (1.f / DM) + EPS_);
#pragma unroll
        for (int j = 0; j < 4; ++j) { const f32x4 g0 = ldf16(F.final_norm_g + 512 * j, lb4), g1 = ldf16(F.final_norm_g + 512 * j + 4, lb4);
            f32x4 o0, o1;
#pragma unroll
            for (int i = 0; i < 4; ++i) { o0[i] = acc[j * 8 + i] * rstd * g0[i]; o1[i] = acc[j * 8 + 4 + i] * rstd * g1[i]; }
            *(f32x4*)((char*)(xr + 512 * j) + lb4) = o0; *(f32x4*)((char*)(xr + 512 * j + 4) + lb4) = o1; }
    }
}
template <int MODE> __device__ __forceinline__ att::BlockRef make_ref(Frame& F, int L, int pass) {
    att::BlockRef R;
    if constexpr (MODE == 0) {
        const int p = L >> 9, rem = L & 511, h = rem & 7, idx = rem >> 3, d = (p == 0) ? 1 : (p == 1 ? 4 : 16), nbp = 64 / d, r = idx / nbp, b = idx % nbp;
        const bf16_t* pj = WSP(bf16_t, WS_PROJ) + (size_t)r * D_INP + h * 128;
        R.Q = pj; R.K = pj + 1024; R.V = pj + 2048; R.qs = R.ks = R.vs = d * D_INP;
        R.O = WSP(bf16_t, WS_OSWA) + ((size_t)p * S_ + r) * 1024 + h * 128; R.os = d * 1024;
        R.QR = nullptr; R.KR = nullptr;
        R.POS = WSP(float, WS_POSF) + r; R.ps = d; R.LSE = WSP(float, WS_LSE) + ((size_t)p * S_ + r) * 8 + h; R.ls = d * 8;
        R.P0 = 256 * b; R.skv = S_ / d; R.W = 129; R.slopeS = __builtin_amdgcn_exp2f(-(float)(h + 1)) * (1.f / att::Cfg<0>::SCALE);
    } else {
        const int h = L & 7, xx = L >> 3, qb = pass == 0 ? xx : 63 - xx;
        R.Q = WSP(bf16_t, WS_QM) + h * 128; R.QR = WSP(bf16_t, WS_QM) + 1024 + h * 64; R.qs = 1536;
        R.K = WSP(bf16_t, WS_KV) + h * 256; R.V = R.K + 128; R.ks = R.vs = 2048; R.KR = WSP(bf16_t, WS_KR);
        R.O = WSP(bf16_t, WS_OMLA) + h * 128; R.os = 1024;
        R.POS = nullptr; R.LSE = nullptr; R.ps = 0; R.ls = 0;
        R.P0 = 256 * qb; R.skv = S_; R.W = 1 << 30; R.slopeS = 0.f;
    }
    return R;
}
template <int MODE> __device__ __forceinline__ void attn_stream(Frame& F) {
    constexpr int PER = MODE == 0 ? 1 : 2, TOTAL = MODE == 0 ? 1536 : 256;
    int L = F.bid; if (L >= TOTAL) return;
    int pass = 0;
    att::BlockRef cur = make_ref<MODE>(F, L, pass);
    att::Seam<MODE> S;
    att::attn_prime<MODE>(cur, F.ldsg, F.lds, S);
    for (;;) {
        int Ln = L, passn = pass + 1; bool last = false;
        if (passn == PER) { passn = 0; Ln = L + F.G; if (Ln >= TOTAL) { last = true; Ln = L; passn = pass; } }
        const att::BlockRef nxt = last ? cur : make_ref<MODE>(F, Ln, passn);
#ifndef ATT_PIPE
#define ATT_PIPE 0
#endif
        if constexpr (((ATT_PIPE >> MODE) & 1) != 0) att::attn_block_pipe<MODE>(cur, nxt, F.ldsg, F.lds, S); else att::attn_block<MODE>(cur, nxt, F.ldsg, F.lds, S);
        if (last) break;
        cur = nxt; L = Ln; pass = passn;
    }
}

constexpr int N_PHASES = 16;
struct Args { const void* in[24]; float* out; unsigned char* ws; int ph_lo, ph_hi, li, pad; };
__global__ void __launch_bounds__(NWAVES * 64, 2) mk_fwd(Args args) {
    extern __shared__ __attribute__((aligned(16))) unsigned char lds[];
    Frame F;
    F.lds = (LAS unsigned char*)lds; F.ldsg = (char*)lds;
    F.MISC = (volatile LAS unsigned*)(F.lds + MISC_OFF);
    FRESH(F);
    F.G = gridDim.x; F.bid = blockIdx.x;
    F.ws = args.ws; F.ctl = (unsigned*)(args.ws + WS_CTL);
    F.x = (const float*)args.in[0]; F.c = (const float*)args.in[1]; F.positions = (const int*)args.in[2]; F.norm_attn_g = (const float*)args.in[3];
    F.w_ada = (const float*)args.in[4]; F.b_ada = (const float*)args.in[5]; F.w_in = (const float*)args.in[6]; F.g_q = (const float*)args.in[7];
    F.w_uq = (const float*)args.in[8]; F.g_kv = (const float*)args.in[9]; F.w_ukv = (const float*)args.in[10]; F.g_out_swa = (const float*)args.in[11];
    F.g_out_mla = (const float*)args.in[12]; F.w_o = (const float*)args.in[13]; F.norm_ffn_g = (const float*)args.in[14]; F.w_router = (const float*)args.in[15];
    F.router_bias = (const float*)args.in[16]; F.w_exp_gate = (const float*)args.in[17]; F.w_exp_up = (const float*)args.in[18]; F.w_exp_down = (const float*)args.in[19];
    F.w_sh_gate = (const float*)args.in[20]; F.w_sh_up = (const float*)args.in[21]; F.w_sh_down = (const float*)args.in[22]; F.final_norm_g = (const float*)args.in[23];
    F.out = args.out;
    for (int u = F.tid; u < 256; u += NWAVES * 64) ((LAS unsigned*)(F.lds + LDSCTL_OFF))[u] = 0u;
    __syncthreads();
    XcdBarrier bar; bar.bar = F.ctl + CW_BAR; bar.x = 0; bar.st = nullptr;
    if (MK_N_LAUNCHES == 1) bar = xcd_barrier_post(F.ctl + CW_BAR, F.MISC + 8);
    const int lo = args.ph_lo, hi = args.ph_hi;
#ifndef PH_MASK
#define PH_MASK 0xFFFF
#endif
#define IN(k) (((PH_MASK >> (k)) & 1) && lo <= (k) && (k) < hi)
#define SEAM(k) do { if (IN(k) && IN((k) + 1)) xcd_barrier(bar); } while (0)
#ifndef PROBE_REPEAT
#define PROBE_REPEAT -1
#endif
#ifndef PROBE_SKIP
#define PROBE_SKIP 1
#endif
#ifndef PROBE_MASK
#define PROBE_MASK 0
#endif
#define REP(k) for (int rep_ = 0; rep_ < ((PROBE_REPEAT == (k) || ((k) < 32 && ((PROBE_MASK >> (k)) & 1))) ? 2 : 1); ++rep_)
    const int NGW = F.G * NWAVES;
    float* modv = WSP(float, WS_MODV);

    if (IN(0)) { FRESH(F); REP(0) { p0_prologue(F); } } SEAM(0);
    if (IN(1)) { FRESH(F); p1_mod(F); } SEAM(1);
    if (IN(2)) REP(2) { FRESH(F); const int gw = F.bid * NWAVES + F.wave; for (int t = gw; t < S_; t += NGW) norm_mod_row(F.x + (size_t)t * DM, modv, modv + 2048, WSP(bf16_t, WS_H) + (size_t)t * DM, F.lane); } SEAM(2);
    if (IN(3)) REP(3) {
        pg8::Gemm g{WSP(bf16_t, WS_H), WSP(bf16_t, WS_WIN), DM, DM}; pg8::StaticOrder S; S.init(S_, D_INP, F.G, F.bid);
        pg8::EpiBf16R E{WSP(bf16_t, WS_PROJ), D_INP, nullptr};
        pg8::gemm_phase(F.lds, g, S, E, pg8::RowIdent{});
    } SEAM(3);
    if (IN(4)) REP(4) { FRESH(F); p3_prep(F); } SEAM(4);
    if (IN(5)) REP(5) {
        { pg8::Gemm g{WSP(bf16_t, WS_PROJ) + 3072, WSP(bf16_t, WS_WUQ), D_INP, 512}; pg8::StaticOrder S; S.init(S_, 1536, F.G, F.bid);
          pg8::EpiQ E{WSP(bf16_t, WS_QM), WSP(float, WS_RQ), WSP(float, WS_COS), WSP(float, WS_SIN)};
          pg8::gemm_phase(F.lds, g, S, E, pg8::RowIdent{}); }
        { pg8::Gemm g{WSP(bf16_t, WS_PROJ) + 3584, WSP(bf16_t, WS_WUKV), D_INP, 256}; pg8::StaticOrder S; S.init(S_, 2048, F.G, F.bid);
          pg8::EpiBf16R E{WSP(bf16_t, WS_KV), 2048, WSP(float, WS_RKV)};
          pg8::gemm_phase(F.lds, g, S, E, pg8::RowIdent{}); }
    } SEAM(5);
    #ifndef ATT_SEL
#define ATT_SEL 3
#endif
    if (IN(6)) { REP(60) { attn_stream<0>(F); __syncthreads(); } REP(61) { attn_stream<1>(F); __syncthreads(); } } SEAM(6);
    if (IN(7)) REP(7) { FRESH(F); p6_mix(F); } SEAM(7);
    if (IN(8)) REP(8) {
        pg8::Gemm g{WSP(bf16_t, WS_MIX), WSP(bf16_t, WS_WO), DM, DM}; pg8::StaticOrder S; S.init(S_, DM, F.G, F.bid);
        pg8::EpiWo E{F.x, modv + 2 * 2048, F.out};
        pg8::gemm_phase(F.lds, g, S, E, pg8::RowIdent{});
    } SEAM(8);
    if (IN(9)) REP(9) { FRESH(F); const int gw = F.bid * NWAVES + F.wave; for (int t = gw; t < S_; t += NGW) norm_mod_row(F.out + (size_t)t * DM, modv + 3 * 2048, modv + 4 * 2048, WSP(bf16_t, WS_H) + (size_t)t * DM, F.lane); } SEAM(9);
    if (IN(10)) REP(10) {
        pg8::Gemm g{WSP(bf16_t, WS_H), WSP(bf16_t, WS_WR), DM, DM}; pg8::StaticOrder S; S.init(S_, 256, F.G, F.bid);
        pg8::EpiLogits E{WSP(float, WS_LOGIT)};
        pg8::gemm_phase(F.lds, g, S, E, pg8::RowIdent{});
    } SEAM(10);
    if (IN(11)) REP(11) { FRESH(F); p10_route(F); } SEAM(11);
    if (IN(12)) { FRESH(F); p11_slots(F); } SEAM(12);
    if (IN(13) || IN(14)) {
        FRESH(F);
        LAS int* xlist = (LAS int*)(F.lds + TILE_OFF);
        LAS int* xcnt = (LAS int*)(F.lds + LDSCTL_OFF + 512);
        #ifndef XCD_CONTIG
#define XCD_CONTIG 0
#endif
        const int xcd = XCD_CONTIG ? (F.bid >> 5) : (F.bid & 7), xrank = XCD_CONTIG ? (F.bid & 31) : (F.bid >> 3), xstride = F.G >> 3;
#ifndef ORDER1
#define ORDER1 0
#endif
#ifndef FLAT_G1
#define FLAT_G1 1
#endif
#ifndef FLAT_G2
#define FLAT_G2 1
#endif
#ifndef ORDER2
#define ORDER2 0
#endif
        LAS int* flist = xlist + MAX_TILES;
        if (F.tid == 0) {
            const int* te = WSP(int, WS_TILEE); int n = 0;
            for (int e = xcd; e < NEXP; e += 8) { const int t0 = te[e], nt_ = te[128 + e]; for (int i = 0; i < nt_ && n < MAX_TILES; ++i) xlist[n++] = ((t0 + i) << 8) | e; }
            { const int t0 = te[NEXP], per = (S_ / 256) / 8; for (int i = 0; i < per && n < MAX_TILES; ++i) xlist[n++] = ((t0 + xcd * per + i) << 8) | NEXP; }
            xcnt[0] = n;
        }
        if (F.tid == 64) {
            const int* te = WSP(int, WS_TILEE); int n = 0;
            for (int e = 0; e < NE1; ++e) { const int t0 = te[e], nt_ = te[128 + e]; for (int i = 0; i < nt_ && n < MAX_TILES; ++i) flist[n++] = ((t0 + i) << 8) | e; }
            xcnt[1] = n;
        }
        __syncthreads();
        const int nfl = xcnt[1];
        const int ntx = xcnt[0];
        if (IN(13)) REP(13) {
            pg8::Gemm g{WSP(bf16_t, WS_H), WSP(bf16_t, WS_WG1), DM, DM};
            pg8::EpiAct E{WSP(bf16_t, WS_ACT)};
            if (ORDER1) { pg8::GroupedOrder S{xlist, 4, ntx * 4, xstride, xrank}; pg8::gemm_phase(F.lds, g, S, E, pg8::RowGather{WSP(int, WS_STOK)}); }
            else { pg8::GroupedFlat S{flist, 4, nfl, FLAT_G1, F.bid}; pg8::gemm_phase(F.lds, g, S, E, pg8::RowGather{WSP(int, WS_STOK)}); }
        }
        SEAM(13);
        if (IN(14)) REP(14) {
            pg8::Gemm g{WSP(bf16_t, WS_ACT), WSP(bf16_t, WS_WG2), 512, 512};
            pg8::EpiDown E{WSP(bf16_t, WS_YS), F.out, modv + 5 * 2048, WSP(int, WS_SDST), WSP(float, WS_SW), WSP(int, WS_STOK), rep_ * PROBE_SKIP};
            if (ORDER2) { pg8::GroupedOrder S{xlist, 8, ntx * 8, xstride, xrank}; pg8::gemm_phase(F.lds, g, S, E, pg8::RowIdent{}); }
            else { pg8::GroupedFlat S{flist, 8, nfl, FLAT_G2, F.bid}; pg8::gemm_phase(F.lds, g, S, E, pg8::RowIdent{}); }
        }
    }
    SEAM(14);
    if (IN(15)) { FRESH(F); p14_final(F); }
#undef IN
#undef SEAM
}

extern "C" void kernel_launch(void* const* d_in, const int* in_sizes, int n_in, void* d_out, int out_size, void* d_ws, size_t ws_size, hipStream_t stream) {
    static int grid = 0;
    if (grid == 0) {
        if (n_in != 24 || in_sizes[0] != S_ * DM || out_size != S_ * DM || ws_size < WS_END) {
            fprintf(stderr, "kernel_launch: unexpected shapes (n_in %d, in0 %d, out %d, ws %zu < %zu?); nothing launched\n", n_in, n_in > 0 ? in_sizes[0] : -1, out_size, ws_size, (size_t)WS_END); grid = -1; return; }
        int dev = 0, cus = 0, per_cu = 0;
        if (hipGetDevice(&dev) != hipSuccess || hipDeviceGetAttribute(&cus, hipDeviceAttributeMultiprocessorCount, dev) != hipSuccess) { fprintf(stderr, "kernel_launch: device query failed\n"); grid = -1; return; }
        if (hipFuncSetAttribute((const void*)mk_fwd, hipFuncAttributeMaxDynamicSharedMemorySize, LDS_BYTES) != hipSuccess) { fprintf(stderr, "kernel_launch: hipFuncSetAttribute failed\n"); grid = -1; return; }
        if (hipOccupancyMaxActiveBlocksPerMultiprocessor(&per_cu, (const void*)mk_fwd, NWAVES * 64, LDS_BYTES) != hipSuccess || per_cu < 1)
            fprintf(stderr, "kernel_launch: note: occupancy query reports %d workgroups per CU\n", per_cu);
        (void)hipGetLastError();
        if (cus < 256) { fprintf(stderr, "kernel_launch: needs 256 CUs (one resident workgroup each), device has %d; nothing launched\n", cus); grid = -1; return; }
        grid = 256;
    }
    if (grid < 0) return;
    if (hipMemsetAsync((char*)d_ws + WS_CTL, 0, CTL_ZERO_BYTES, stream) != hipSuccess) { fprintf(stderr, "kernel_launch: memset failed\n"); return; }
    Args a{};
    for (int i = 0; i < 24; ++i) a.in[i] = d_in[i];
    a.out = (float*)d_out; a.ws = (unsigned char*)d_ws;
#if MK_N_LAUNCHES == 1
    a.ph_lo = 0; a.ph_hi = N_PHASES; a.li = 0;
    hipLaunchKernelGGL(mk_fwd, dim3(grid), dim3(NWAVES * 64), LDS_BYTES, stream, a);
#else
    for (int li = 0; li < N_PHASES; ++li) { a.ph_lo = li; a.ph_hi = li + 1; a.li = li;
        hipLaunchKernelGGL(mk_fwd, dim3(grid), dim3(NWAVES * 64), LDS_BYTES, stream, a); }
#endif
    const hipError_t le = hipPeekAtLastError();
    if (le != hipSuccess) fprintf(stderr, "kernel_launch: launch failed: %s\n", hipGetErrorName(le));
}
```
